# Optimizing an MI355X kernel written in HIP

```python
import jax, jax.numpy as jnp
from jax import lax
import numpy as np

D_MODEL = 1024
BATCH = 2
SEQ = 8192
DEPTH = 4

CHUNK = 64
N_A = DEPTH // 2
N_B = DEPTH - N_A
N_MEM = 256
MEM_HEADS = 4
MEM_HEAD_DIM = D_MODEL // 16
MEM_W = MEM_HEADS * MEM_HEAD_DIM
GM_W = D_MODEL - MEM_W
GM_GROUPS = 6
GM_GC = GM_W // GM_GROUPS
GM_CHUNK = 128
SB_W = D_MODEL - MEM_W
SB_HEAD_DIM = 64
SB_HEADS = SB_W // SB_HEAD_DIM
SB_BLOCK = 128
D_FF = 2816
EPS = 1e-6

kernel_name = "yoco_gmlp_stickbreaking_macaron_memory"


def rms_norm(x, g):
    xf = x.astype(jnp.float32)
    r = lax.rsqrt(jnp.mean(xf * xf, axis=-1, keepdims=True) + EPS)
    return (xf * r).astype(x.dtype) * g


def half_swiglu(x, g, w_gate, w_up, w_down):
    h = rms_norm(x, g)
    return (jax.nn.silu(h @ w_gate) * (h @ w_up)) @ w_down


def memory_attention(q, mem_kv):
    b, s, _ = q.shape
    k, v = jnp.split(mem_kv, 2, axis=-1)
    q = q.reshape(b, s, MEM_HEADS, MEM_HEAD_DIM)
    k = k.reshape(b, N_MEM, MEM_HEADS, MEM_HEAD_DIM)
    v = v.reshape(b, N_MEM, MEM_HEADS, MEM_HEAD_DIM)
    scores = jnp.einsum('bshd,bmhd->bhsm', q, k).astype(jnp.float32) * (MEM_HEAD_DIM ** -0.5)
    p = jax.nn.softmax(scores, axis=-1).astype(v.dtype)
    return jnp.einsum('bhsm,bmhd->bshd', p, v).reshape(b, s, MEM_W)


def gmlp_chunk_mask():
    pos = np.arange(GM_CHUNK)
    return jnp.asarray((pos[None, :] // CHUNK) <= (pos[:, None] // CHUNK))


def gmlp_spatial_gating(u, v, v_gain, w_s, b_s):
    b, s, _ = u.shape
    v = rms_norm(v, v_gain)
    vb = v.reshape(b, s // GM_CHUNK, GM_CHUNK, GM_GROUPS, GM_GC)
    w = jnp.where(gmlp_chunk_mask()[None], w_s, 0.0).astype(v.dtype)
    mixed = jnp.einsum('gts,bnsgc->bntgc', w, vb) + b_s.T[None, None, :, :, None]
    return u * mixed.reshape(b, s, GM_W)


def stick_breaking_attention(q, k, v):
    b, s, h, d = q.shape
    nblk = s // SB_BLOCK
    qb = q.reshape(b, nblk, SB_BLOCK, h, d).transpose(1, 0, 2, 3, 4)
    starts = jnp.arange(nblk, dtype=jnp.int32) * SB_BLOCK
    key_pos = jnp.arange(s, dtype=jnp.int32)
    scale = d ** -0.5

    def block(args):
        qi, start = args
        z = jnp.einsum('bqhd,bkhd->bhqk', qi, k).astype(jnp.float32) * scale
        qpos = start + jnp.arange(SB_BLOCK, dtype=jnp.int32)
        causal = key_pos[None, :] < qpos[:, None]
        log_beta = jax.nn.log_sigmoid(z)
        log_one_minus = jnp.where(causal, jax.nn.log_sigmoid(-z), 0.0)
        suffix = lax.cumsum(log_one_minus, axis=3, reverse=True) - log_one_minus
        a = jnp.where(causal, jnp.exp(log_beta + suffix), 0.0).astype(v.dtype)
        return jnp.einsum('bhqk,bkhd->bqhd', a, v)

    out = lax.map(block, (qb, starts))
    return out.transpose(1, 0, 2, 3, 4).reshape(b, s, h * d)


def setup_inputs(seed: int = 0) -> dict:
    key = jax.random.key(seed)
    ks = iter(jax.random.split(key, 32))
    f32 = jnp.float32

    def w(shape, fan_in):
        return jax.random.normal(next(ks), shape, f32) * (fan_in ** -0.5)

    def gain(shape):
        return 1.0 + 0.02 * jax.random.normal(next(ks), shape, f32)

    return {
        "x": jax.random.normal(next(ks), (BATCH, SEQ, D_MODEL), f32),
        "mem": jax.random.normal(next(ks), (BATCH, N_MEM, D_MODEL), f32),
        "ffn1_norm": gain((DEPTH, D_MODEL)),
        "ffn1_w_gate": w((DEPTH, D_MODEL, D_FF), D_MODEL),
        "ffn1_w_up": w((DEPTH, D_MODEL, D_FF), D_MODEL),
        "ffn1_w_down": w((DEPTH, D_FF, D_MODEL), D_FF),
        "mix_norm": gain((DEPTH, D_MODEL)),
        "ffn2_norm": gain((DEPTH, D_MODEL)),
        "ffn2_w_gate": w((DEPTH, D_MODEL, D_FF), D_MODEL),
        "ffn2_w_up": w((DEPTH, D_MODEL, D_FF), D_MODEL),
        "ffn2_w_down": w((DEPTH, D_FF, D_MODEL), D_FF),
        "mem_norm": gain((D_MODEL,)),
        "w_mem_kv": w((DEPTH, D_MODEL, 2 * MEM_W), D_MODEL),
        "a_w_in": w((N_A, D_MODEL, 2 * GM_W + MEM_W), D_MODEL),
        "a_v_norm": gain((N_A, GM_W)),
        "a_w_spatial": w((N_A, GM_GROUPS, GM_CHUNK, GM_CHUNK), GM_CHUNK),
        "a_b_spatial": gain((N_A, GM_GROUPS, GM_CHUNK)),
        "a_w_out": w((N_A, GM_W + MEM_W, D_MODEL), GM_W + MEM_W),
        "kv_norm": gain((D_MODEL,)),
        "w_kv": w((D_MODEL, 2 * SB_W), D_MODEL),
        "b_w_in": w((N_B, D_MODEL, SB_W + MEM_W), D_MODEL),
        "b_w_out": w((N_B, SB_W + MEM_W, D_MODEL), SB_W + MEM_W),
        "final_norm": gain((D_MODEL,)),
    }


def reference(x, mem, ffn1_norm, ffn1_w_gate, ffn1_w_up, ffn1_w_down, mix_norm,
              ffn2_norm, ffn2_w_gate, ffn2_w_up, ffn2_w_down, mem_norm, w_mem_kv,
              a_w_in, a_v_norm, a_w_spatial, a_b_spatial, a_w_out,
              kv_norm, w_kv, b_w_in, b_w_out, final_norm):
    b, s, _ = x.shape
    mem_h = rms_norm(mem, mem_norm)
    shared_k = shared_v = None
    for l in range(DEPTH):
        if l == N_A:
            kv = rms_norm(x, kv_norm) @ w_kv
            shared_k, shared_v = jnp.split(kv, 2, axis=-1)
            shared_k = shared_k.reshape(b, s, SB_HEADS, SB_HEAD_DIM)
            shared_v = shared_v.reshape(b, s, SB_HEADS, SB_HEAD_DIM)

        x = x + 0.5 * half_swiglu(x, ffn1_norm[l], ffn1_w_gate[l], ffn1_w_up[l], ffn1_w_down[l])

        h = rms_norm(x, mix_norm[l])
        mem_kv = mem_h @ w_mem_kv[l]
        if l < N_A:
            i = l
            proj = h @ a_w_in[i]
            uv = jax.nn.gelu(proj[..., :2 * GM_W])
            u, v = uv[..., :GM_W], uv[..., GM_W:]
            q_mem = proj[..., 2 * GM_W:]
            y_tok = gmlp_spatial_gating(u, v, a_v_norm[i], a_w_spatial[i], a_b_spatial[i])
            y = jnp.concatenate([y_tok, memory_attention(q_mem, mem_kv)], axis=-1)
            x = x + y @ a_w_out[i]
        else:
            j = l - N_A
            proj = h @ b_w_in[j]
            q_sb = proj[..., :SB_W].reshape(b, s, SB_HEADS, SB_HEAD_DIM)
            q_mem = proj[..., SB_W:]
            y_tok = stick_breaking_attention(q_sb, shared_k, shared_v)
            y = jnp.concatenate([y_tok, memory_attention(q_mem, mem_kv)], axis=-1)
            x = x + y @ b_w_out[j]

        x = x + 0.5 * half_swiglu(x, ffn2_norm[l], ffn2_w_gate[l], ffn2_w_up[l], ffn2_w_down[l])
    return rms_norm(x, final_norm)
```

```cpp
#include <hip/hip_runtime.h>
#include <hip/hip_cooperative_groups.h>
#include <cstdio>
#include <cstdint>
namespace cg = cooperative_groups;
__device__ __forceinline__ int lane_id_opaque() { int l = __builtin_amdgcn_mbcnt_hi(~0u, __builtin_amdgcn_mbcnt_lo(~0u, 0u)); asm volatile("" : "+v"(l)); return l; }
namespace pg8 {
#define PG8_LAS __attribute__((address_space(3)))
typedef unsigned short bf16_t;
typedef short bf16x8 __attribute__((ext_vector_type(8)));
typedef float f32x4 __attribute__((ext_vector_type(4)));
typedef unsigned u32x4 __attribute__((ext_vector_type(4)));
constexpr int BM = 256, BK = 64, HALF = 128, HTB = HALF * BK * 2  , STAGE_BYTES = 8 * HTB, NXCD = 8, WGM = 8;

__host__ __device__ __forceinline__ int lds_byte(int r, int c) { const int st = (r >> 4) * 2 + (c >> 5), rr = r & 15, cc = c & 31, ob = rr * 64 + cc * 2; return st * 1024 + (ob ^ (((ob >> 9) & 1) << 5)); }
__host__ __device__ __forceinline__ void stage_rc(int b, int& R, int& C) { const int st = b / 1024, sb = b % 1024, swz = sb ^ (((sb >> 9) & 1) << 5); R = (st >> 1) * 16 + swz / 64; C = (st & 1) * 32 + (swz % 64) / 2; }
__host__ __device__ __forceinline__ int perm32(int rho) { const int n = rho >> 4, i = rho & 15; return 8 * (i >> 2) + 4 * n + (i & 3); }

struct Unit { int pm, pn, ord; };
struct Gemm { const bf16_t* A; const bf16_t* Bt; int M, N, K; };

struct StaticOrder {
    int nM, nN, nwg, G, c;
    __host__ __device__ void init(int M, int N, int G_, int c_) { nM = M / BM; nN = N / BM; nwg = nM * nN; G = G_; c = c_; }
    __host__ __device__ bool next(int i, Unit& u) const {
        const long L = (long)i * G + c; if (L >= nwg) return false;
        int wgid = (int)L; { const int q = nwg / NXCD, r = nwg % NXCD, xcd = wgid % NXCD, off = wgid / NXCD; wgid = (xcd < r ? xcd * (q + 1) : r * (q + 1) + (xcd - r) * q) + off; }
        const int nig = WGM * nN, gid = wgid / nig, fm = gid * WGM, gsz = (nM - fm) < WGM ? (nM - fm) : WGM;
        u.pm = fm + ((wgid % nig) % gsz); u.pn = (wgid % nig) / gsz; u.ord = i; return true;
    }
    __device__ __forceinline__ void a_ready(const Unit&) const {}
    __device__ __forceinline__ void done(const Unit&) const {}
};

__device__ __forceinline__ unsigned cvt_pk_bf16(float lo, float hi) { unsigned r; asm volatile("v_cvt_pk_bf16_f32 %0, %1, %2" : "=v"(r) : "v"(lo), "v"(hi)); return r; }
typedef float f32x2 __attribute__((ext_vector_type(2)));
template <class Epi, class Sched, bool ALIGN_EPI = false, bool SP2 = false>
__device__ __forceinline__ void gemm_phase(PG8_LAS unsigned char* lds, const Gemm g, const Sched& S, const Epi& E, const int wave_id) {
    const int tid_ = wave_id * 64 + lane_id_opaque();
    const int tid = tid_, wid = __builtin_amdgcn_readfirstlane(tid >> 6), lane = tid & 63, wr = wid >> 2, wc = wid & 3, fr = lane & 15, fq = lane >> 4;
    const int K = g.K, nt = K / BK;
    unsigned voffA[2], voffB[2];
#pragma unroll
    for (int i = 0; i < 2; ++i) { int R, C; stage_rc(tid * 16 + i * 8192, R, C); const int Rb = Epi::PERM ? ((R & ~31) + perm32(R & 31)) : R;
        voffA[i] = (unsigned)(R * K + C) * 2u; voffB[i] = (unsigned)(Rb * K + C) * 2u; }
    const size_t kstep = (size_t)(BK * 2);
    const size_t hstep = (size_t)HALF * K * 2;
    const size_t tstep = 2 * hstep;
    const unsigned ldsw = (unsigned)wid * 1024u;
    const int aoff = lds_byte(wr * 64 + fr, fq * 8), boff = lds_byte(wc * 32 + fr, fq * 8);
#define PG8_SA(b, h) (((b) * 2 + (h)) * HTB)
#define PG8_SB(b, h) ((4 + (b) * 2 + (h)) * HTB)
#define PG8_STAGE(bufoff, gbase, voff) do { _Pragma("unroll") for (int _i = 0; _i < 2; ++_i) \
        __builtin_amdgcn_global_load_lds((const unsigned*)((const char*)(gbase) + (voff)[_i]), (PG8_LAS unsigned*)(lds + (bufoff) + ldsw + _i * 8192), 16, 0, 0); } while (0)
#define PG8_LDA(dst, b, h) do { _Pragma("unroll") for (int m = 0; m < 4; ++m) _Pragma("unroll") for (int k = 0; k < 2; ++k) dst[m][k] = *(const PG8_LAS bf16x8*)(lds + PG8_SA(b, h) + aoff + m * 2048 + k * 1024); } while (0)
#define PG8_LDB(dst, b, h) do { _Pragma("unroll") for (int n = 0; n < 2; ++n) _Pragma("unroll") for (int k = 0; k < 2; ++k) dst[n][k] = *(const PG8_LAS bf16x8*)(lds + PG8_SB(b, h) + boff + n * 2048 + k * 1024); } while (0)
#define PG8_MMA(ai, bj, At, Bt) do { __builtin_amdgcn_s_setprio(1); _Pragma("unroll") for (int m = 0; m < 4; ++m) _Pragma("unroll") for (int n = 0; n < 2; ++n) _Pragma("unroll") for (int k = 0; k < 2; ++k) \
        acc[ai][bj][m][n] = __builtin_amdgcn_mfma_f32_16x16x32_bf16(Bt[n][k], At[m][k], acc[ai][bj][m][n], 0, 0, 0); __builtin_amdgcn_s_setprio(0); } while (0)
#define PG8_WAIT_V(n) asm volatile("s_waitcnt vmcnt(" #n ")" ::: "memory")
#define PG8_WAIT_L(n) asm volatile("s_waitcnt lgkmcnt(" #n ")" ::: "memory")
#define PG8_BAR __builtin_amdgcn_s_barrier()
#define PG8_SCHED __builtin_amdgcn_sched_barrier(0)
    Unit cur, nxt; int ui = 0;
    if (!S.next(0, cur)) return;
    f32x4 acc[2][2][4][2];
#pragma unroll
    for (int a = 0; a < 2; ++a)
#pragma unroll
        for (int b = 0; b < 2; ++b)
#pragma unroll
            for (int m = 0; m < 4; ++m)
#pragma unroll
                for (int n = 0; n < 2; ++n) acc[a][b][m][n] = (f32x4){0.f, 0.f, 0.f, 0.f};
    bf16x8 At[4][2], B0[2][2], B1[2][2];
    const char* cA = (const char*)g.A + (size_t)cur.pm * tstep; const char* cB = (const char*)g.Bt + (size_t)cur.pn * tstep;
    S.a_ready(cur);
    if constexpr (SP2) {
        PG8_STAGE(PG8_SB(0, 0), cB, voffB); PG8_STAGE(PG8_SB(0, 1), cB + hstep, voffB); PG8_STAGE(PG8_SA(0, 0), cA, voffA); PG8_STAGE(PG8_SA(0, 1), cA + hstep, voffA);
        if (wr == 1) PG8_BAR;
        PG8_WAIT_V(2); PG8_BAR;
        PG8_STAGE(PG8_SB(1, 0), cB + kstep, voffB); PG8_STAGE(PG8_SA(1, 0), cA + kstep, voffA); PG8_STAGE(PG8_SB(1, 1), cB + hstep + kstep, voffB);
        PG8_WAIT_V(6); PG8_BAR;
    } else {
        PG8_STAGE(PG8_SB(0, 0), cB, voffB); PG8_STAGE(PG8_SA(0, 0), cA, voffA); PG8_STAGE(PG8_SB(0, 1), cB + hstep, voffB); PG8_STAGE(PG8_SA(0, 1), cA + hstep, voffA);
        if (wr == 1) PG8_BAR;
        PG8_WAIT_V(4); PG8_BAR;
        PG8_STAGE(PG8_SB(1, 0), cB + kstep, voffB); PG8_STAGE(PG8_SA(1, 0), cA + kstep, voffA); PG8_STAGE(PG8_SB(1, 1), cB + hstep + kstep, voffB);
        PG8_WAIT_V(6); PG8_BAR;
    }
    for (;;) {
        const bool has_next = S.next(ui + 1, nxt);
        const char* nA = has_next ? (const char*)g.A + (size_t)nxt.pm * tstep : cA; const char* nB = has_next ? (const char*)g.Bt + (size_t)nxt.pn * tstep : cB;
        for (int t = 0; t < nt; t += 2) {
            const bool last = (t == nt - 2);
            const char* a1 = cA + (size_t)(t + 1) * kstep;
            const char* a2 = last ? nA : cA + (size_t)(t + 2) * kstep; const char* b2 = last ? nB : cB + (size_t)(t + 2) * kstep;
            const char* a3 = a2 + kstep; const char* b3 = b2 + kstep;
            if (last && has_next) S.a_ready(nxt);
            if constexpr (SP2) {
            PG8_LDB(B0, 0, 0); PG8_LDB(B1, 0, 1); PG8_SCHED; PG8_LDA(At, 0, 0); PG8_STAGE(PG8_SA(1, 1), a1 + hstep, voffA);
            PG8_WAIT_V(8); PG8_WAIT_L(0); PG8_BAR; PG8_MMA(0, 0, At, B0); PG8_MMA(0, 1, At, B1); PG8_BAR; PG8_SCHED;
            PG8_LDA(At, 0, 1); PG8_STAGE(PG8_SB(0, 0), b2, voffB); PG8_STAGE(PG8_SB(0, 1), b2 + hstep, voffB); PG8_STAGE(PG8_SA(0, 0), a2, voffA);
            PG8_WAIT_V(8); PG8_WAIT_L(0); PG8_BAR; PG8_MMA(1, 0, At, B0); PG8_MMA(1, 1, At, B1); PG8_BAR; PG8_SCHED;
            PG8_LDB(B0, 1, 0); PG8_LDB(B1, 1, 1); PG8_SCHED; PG8_LDA(At, 1, 0); PG8_STAGE(PG8_SA(0, 1), a2 + hstep, voffA);
            PG8_WAIT_V(8); PG8_WAIT_L(0); PG8_BAR; PG8_MMA(0, 0, At, B0); PG8_MMA(0, 1, At, B1); PG8_BAR; PG8_SCHED;
            PG8_LDA(At, 1, 1); PG8_STAGE(PG8_SB(1, 0), b3, voffB); PG8_STAGE(PG8_SB(1, 1), b3 + hstep, voffB); PG8_STAGE(PG8_SA(1, 0), a3, voffA);
            PG8_WAIT_V(8); PG8_WAIT_L(0); PG8_BAR; PG8_MMA(1, 0, At, B0); PG8_MMA(1, 1, At, B1); PG8_BAR; PG8_SCHED;
            } else {
            PG8_LDB(B0, 0, 0); PG8_SCHED; PG8_LDA(At, 0, 0); PG8_STAGE(PG8_SA(1, 1), a1 + hstep, voffA);
            PG8_WAIT_L(8); PG8_BAR; PG8_WAIT_L(0); PG8_MMA(0, 0, At, B0); PG8_BAR; PG8_SCHED;
            PG8_LDB(B1, 0, 1); PG8_STAGE(PG8_SB(0, 0), b2, voffB);
            PG8_BAR; PG8_WAIT_L(0); PG8_MMA(0, 1, At, B1); PG8_BAR;
            PG8_LDA(At, 0, 1); PG8_STAGE(PG8_SA(0, 0), a2, voffA);
            PG8_BAR; PG8_WAIT_L(0); PG8_MMA(1, 0, At, B0); PG8_BAR; PG8_SCHED;
            PG8_STAGE(PG8_SB(0, 1), b2 + hstep, voffB);
            PG8_WAIT_V(6); PG8_BAR; PG8_MMA(1, 1, At, B1); PG8_BAR;
            PG8_LDB(B0, 1, 0); PG8_SCHED; PG8_LDA(At, 1, 0); PG8_STAGE(PG8_SA(0, 1), a2 + hstep, voffA);
            PG8_WAIT_L(8); PG8_BAR; PG8_WAIT_L(0); PG8_MMA(0, 0, At, B0); PG8_BAR; PG8_SCHED;
            PG8_LDB(B1, 1, 1); PG8_STAGE(PG8_SB(1, 0), b3, voffB);
            PG8_BAR; PG8_WAIT_L(0); PG8_MMA(0, 1, At, B1); PG8_BAR;
            PG8_LDA(At, 1, 1); PG8_STAGE(PG8_SA(1, 0), a3, voffA);
            PG8_BAR; PG8_WAIT_L(0); PG8_MMA(1, 0, At, B0); PG8_BAR; PG8_SCHED;
            PG8_STAGE(PG8_SB(1, 1), b3 + hstep, voffB);
            PG8_WAIT_V(6); PG8_BAR; PG8_MMA(1, 1, At, B1); PG8_BAR;
            }
        }
        if constexpr (ALIGN_EPI) { if (wr == 0) PG8_BAR; }
        if constexpr (!Epi::AFTER_DRAIN) { E(acc, cur, wr, wc, fr, fq); S.done(cur); }
        if (!has_next) break;
#pragma unroll
        for (int a = 0; a < 2; ++a)
#pragma unroll
            for (int b = 0; b < 2; ++b)
#pragma unroll
                for (int m = 0; m < 4; ++m)
#pragma unroll
                    for (int n = 0; n < 2; ++n) acc[a][b][m][n] = (f32x4){0.f, 0.f, 0.f, 0.f};
        cur = nxt; cA = nA; cB = nB; ++ui;
        if constexpr (ALIGN_EPI) { if (wr == 1) PG8_BAR; }
    }
    PG8_WAIT_V(0);
    if constexpr (!ALIGN_EPI) { if (wr == 0) PG8_BAR; }
    PG8_BAR;
    if constexpr (Epi::AFTER_DRAIN) { E.fused(acc, cur, wr, wc, fr, fq, lds, wid, lane); S.done(cur); }
#undef PG8_SA
#undef PG8_SB
#undef PG8_STAGE
#undef PG8_LDA
#undef PG8_LDB
#undef PG8_MMA
#undef PG8_WAIT_V
#undef PG8_WAIT_L
#undef PG8_BAR
#undef PG8_SCHED
}
}

using pg8::bf16_t; using pg8::f32x4; using pg8::u32x4; using pg8::Unit;
typedef short bf16x8 __attribute__((ext_vector_type(8)));
typedef float f32x16 __attribute__((ext_vector_type(16)));
typedef float f32x2v __attribute__((ext_vector_type(2)));
typedef __bf16 bf16v2 __attribute__((ext_vector_type(2)));
typedef unsigned u32x2 __attribute__((ext_vector_type(2)));
#define LAS __attribute__((address_space(3)))
#define MFMA32(a, b, c) __builtin_amdgcn_mfma_f32_32x32x16_bf16((a), (b), (c), 0, 0, 0)

constexpr int BATCH = 2, SEQ = 8192, DM = 1024, MROWS = BATCH * SEQ, FF = 2816, NMEM = 256, NH = 12;
constexpr float EPS = 1e-6f;
constexpr int NWAVES = 8;

constexpr size_t MiB = 1u << 20;
constexpr size_t WS_CTL = 0, CTL_BYTES = 3 * MiB;
constexpr size_t CTL_ROWSQ = 0;
constexpr size_t CTL_VSQ = 13 * 16384 * 8;
constexpr size_t CTL_MEMSQ = CTL_VSQ + 2 * 16384 * 8;
constexpr size_t CTL_BAR = 2 * MiB;
static_assert(CTL_MEMSQ + 4096 <= CTL_BAR && CTL_BAR + 16384 <= CTL_BYTES, "ctl");
constexpr size_t E_GU = 5632ull * 1024, E_D = 1024ull * 2816, E_INA = 1792ull * 1024, E_OUT = 1024ull * 1024;
constexpr size_t L_GU1 = 0, L_D1 = 7168ull * 1024, L_GU2 = L_D1 + E_D, L_D2 = L_GU2 + E_GU, L_IN = L_D2 + E_D, L_OUT = L_IN + E_INA, L_STRIDE = L_OUT + E_OUT;
constexpr size_t WS_W = 3 * MiB;
constexpr size_t WS_WMEM = WS_W + 4 * L_STRIDE * 2;
constexpr size_t WS_XB = 174 * MiB;
static_assert(WS_WMEM + 2048ull * 1024 * 2 <= WS_XB, "weights region");
constexpr size_t WS_H = 206 * MiB;
constexpr size_t WS_U = WS_H, WS_VTA = WS_H + 24 * MiB, WS_QM = WS_H + 48 * MiB, WS_P = WS_H, WS_Y = WS_H + 56 * MiB;
constexpr size_t WS_K = 294 * MiB, WS_VT = 318 * MiB;
constexpr size_t WS_MEMB = 342 * MiB, WS_KMEM = 343 * MiB, WS_VMEMT = 344 * MiB, WS_END = 345 * MiB;
constexpr int LDS_BYTES = 147456;
#define REP_PRO 1
#define REP_SYNC 1
#define REP_MIX 1
#define REP_GU 1
#define REP_IN 1


struct Params {
    const float *x, *mem, *ffn1_norm, *ffn1_wg, *ffn1_wu, *ffn1_wd, *mix_norm, *ffn2_norm, *ffn2_wg, *ffn2_wu, *ffn2_wd, *mem_norm, *w_mem_kv,
                *a_w_in, *a_v_norm, *a_w_sp, *a_b_sp, *a_w_out, *kv_norm, *w_kv, *b_w_in, *b_w_out, *final_norm;
    float* out; unsigned char* ws;
};

typedef const Params __attribute__((address_space(4)))* cparams_t;
__device__ __forceinline__ cparams_t kparams() { cparams_t k = (cparams_t)__builtin_amdgcn_kernarg_segment_ptr(); asm volatile("" : "+s"(k)); return k; }
__device__ __forceinline__ unsigned pk2(float a, float b) { bf16v2 v = __builtin_convertvector((f32x2v){a, b}, bf16v2); return __builtin_bit_cast(unsigned, v); }
__device__ __forceinline__ float ex2(float x) { return __builtin_amdgcn_exp2f(x); }
__device__ __forceinline__ float lg2(float x) { return __builtin_amdgcn_logf(x); }
__device__ __forceinline__ float rcpf_(float x) { return __builtin_amdgcn_rcpf(x); }
__device__ __forceinline__ float silu_f(float g) { return g * rcpf_(1.f + ex2(-1.4426950408889634f * g)); }
__device__ __forceinline__ float gelu_tanh_f(float x) { const float t = x * (1.f + 0.044715f * x * x); return x * rcpf_(1.f + ex2(-2.f * 0.7978845608028654f * 1.4426950408889634f * t)); }
typedef unsigned long long sq_t;
__device__ __forceinline__ sq_t sq_fix(float ss) { return (sq_t)(long long)(ss * 1048576.f); }
__device__ __forceinline__ void sq_add(sq_t* p, float ss) { atomicAdd(p, sq_fix(ss)); }
__device__ __forceinline__ float sq_read(const sq_t* p) { return (float)(long long)(*p) * (1.f / 1048576.f); }
__device__ __forceinline__ float wave_sum(float v) {
#pragma unroll
    for (int o = 1; o < 64; o <<= 1) v += __shfl_xor(v, o);
    return v;
}

struct EpiSwiGLU {
    static constexpr bool PERM = true, AFTER_DRAIN = false;
    bf16_t* H; const LAS float* rtab; bf16_t* Kb; bf16_t* VTb;
    __device__ __forceinline__ void operator()(const f32x4 (&acc)[2][2][4][2], const Unit& u, int wr, int wc, int fr_in, int fq_in) const {
        int fr = fr_in, fq = fq_in; asm volatile("" : "+v"(fr), "+v"(fq));
        const int row0 = u.pm * 256 + wr * 64 + fr;
        if (u.pn < 22) {
            const int col0 = u.pn * 128 + wc * 32 + 8 * fq;
#pragma unroll
            for (int ai = 0; ai < 2; ++ai)
#pragma unroll
                for (int m = 0; m < 4; ++m) {
                    const int row = row0 + ai * 128 + m * 16;
                    const float rr = rtab[u.ord * 256 + (row & 255)], cexp = -1.4426950408889634f * rr, rr2 = rr * rr;
                    float hv[8];
#pragma unroll
                    for (int n = 0; n < 2; ++n)
#pragma unroll
                        for (int j = 0; j < 4; ++j) { const float g = acc[ai][0][m][n][j]; hv[4 * n + j] = (g * acc[ai][1][m][n][j]) * rcpf_(1.f + ex2(g * cexp)) * rr2; }
                    u32x4 w; w.x = pk2(hv[0], hv[1]); w.y = pk2(hv[2], hv[3]); w.z = pk2(hv[4], hv[5]); w.w = pk2(hv[6], hv[7]);
                    *(u32x4*)(H + (size_t)row * FF + col0) = w;
                }
        } else {
            const int cb = (u.pn - 22) * 256 + wc * 32 + 8 * fq;
#pragma unroll
            for (int ai = 0; ai < 2; ++ai)
#pragma unroll
                for (int m = 0; m < 4; ++m) {
                    const int row = row0 + ai * 128 + m * 16, b = row >> 13, s = row & 8191;
                    const float rr = rtab[u.ord * 256 + (row & 255)];
#pragma unroll
                    for (int bj = 0; bj < 2; ++bj) {
                        const int c8 = cb + bj * 128;
                        float v[8];
#pragma unroll
                        for (int n = 0; n < 2; ++n)
#pragma unroll
                            for (int j = 0; j < 4; ++j) v[4 * n + j] = acc[ai][bj][m][n][j] * rr;
                        if (c8 < 768) {
                            const int hd = c8 >> 6, d = c8 & 63;
                            u32x4 w; w.x = pk2(v[0], v[1]); w.y = pk2(v[2], v[3]); w.z = pk2(v[4], v[5]); w.w = pk2(v[6], v[7]);
                            *(u32x4*)(Kb + ((size_t)(b * NH + hd) * SEQ + s) * 64 + d) = w;
                        } else {
                            const int cv = c8 - 768, hd = cv >> 6, d = cv & 63;
                            bf16_t* vp = VTb + (((size_t)(b * NH + hd) * (SEQ / 64) + (s >> 6)) * 64 + d) * 64 + (s & 63);
#pragma unroll
                            for (int e = 0; e < 8; e += 2) { const unsigned p = pk2(v[e], v[e + 1]); vp[e * 64] = (bf16_t)(p & 0xffffu); vp[(e + 1) * 64] = (bf16_t)(p >> 16); }
                        }
                    }
                }
        }
    }
};
struct EpiResid {
    static constexpr bool PERM = true, AFTER_DRAIN = false;
    bf16_t* XB; sq_t* rsq_out; float alpha;
    __device__ __forceinline__ void operator()(const f32x4 (&acc)[2][2][4][2], const Unit& u, int wr, int wc, int fr_in, int fq_in) const {
        int fr = fr_in, fq = fq_in; asm volatile("" : "+v"(fr), "+v"(fq));
        const int row0 = u.pm * 256 + wr * 64 + fr, col0 = u.pn * 256 + wc * 32 + 8 * fq;
#pragma unroll
        for (int ai = 0; ai < 2; ++ai) {
            u32x4 pre[4][2];
#pragma unroll
            for (int m = 0; m < 4; ++m)
#pragma unroll
                for (int bj = 0; bj < 2; ++bj) pre[m][bj] = *(const u32x4*)(XB + (size_t)(row0 + ai * 128 + m * 16) * DM + col0 + bj * 128);
#pragma unroll
            for (int m = 0; m < 4; ++m) {
                const int row = row0 + ai * 128 + m * 16; float ss = 0.f;
#pragma unroll
                for (int bj = 0; bj < 2; ++bj) {
                    float v[8];
#pragma unroll
                    for (int k = 0; k < 4; ++k) {
                        const unsigned w = pre[m][bj][k];
                        v[2 * k] = __uint_as_float(w << 16) + alpha * acc[ai][bj][m][k >> 1][2 * (k & 1)];
                        v[2 * k + 1] = __uint_as_float(w & 0xffff0000u) + alpha * acc[ai][bj][m][k >> 1][2 * (k & 1) + 1];
                        ss += v[2 * k] * v[2 * k] + v[2 * k + 1] * v[2 * k + 1];
                    }
                    u32x4 o; o.x = pk2(v[0], v[1]); o.y = pk2(v[2], v[3]); o.z = pk2(v[4], v[5]); o.w = pk2(v[6], v[7]);
                    *(u32x4*)(XB + (size_t)row * DM + col0 + bj * 128) = o;
                }
                ss += __shfl_xor(ss, 16); ss += __shfl_xor(ss, 32);
                if (fq == 0) sq_add(rsq_out + row, ss);
            }
            asm volatile("" ::: "memory");
        }
    }
};
struct EpiProjA {
    static constexpr bool PERM = true, AFTER_DRAIN = false;
    bf16_t* U; bf16_t* VTA; bf16_t* QM; const LAS float* rtab; sq_t* vsq;
    __device__ __forceinline__ void operator()(const f32x4 (&acc)[2][2][4][2], const Unit& u, int wr, int wc, int fr_in, int fq_in) const {
        int fr = fr_in, fq = fq_in; asm volatile("" : "+v"(fr), "+v"(fq));
        const int row0 = u.pm * 256 + wr * 64 + fr, cw = wc * 32 + 8 * fq;
#pragma unroll
        for (int ai = 0; ai < 2; ++ai)
#pragma unroll
            for (int m = 0; m < 4; ++m) {
                const int row = row0 + ai * 128 + m * 16, b = row >> 13, s = row & 8191;
                const float rr = rtab[u.ord * 256 + (row & 255)];
                float ss = 0.f;
#pragma unroll
                for (int bj = 0; bj < 2; ++bj) {
                    float v[8];
#pragma unroll
                    for (int n = 0; n < 2; ++n)
#pragma unroll
                        for (int j = 0; j < 4; ++j) v[4 * n + j] = acc[ai][bj][m][n][j] * rr;
                    if (u.pn < 6) {
#pragma unroll
                        for (int e = 0; e < 8; ++e) v[e] = gelu_tanh_f(v[e]);
                    }
                    if (u.pn < 3) {
                        u32x4 w; w.x = pk2(v[0], v[1]); w.y = pk2(v[2], v[3]); w.z = pk2(v[4], v[5]); w.w = pk2(v[6], v[7]);
                        *(u32x4*)(U + (size_t)row * 768 + u.pn * 256 + bj * 128 + cw) = w;
                    } else if (u.pn < 6) {
                        const int cv = (u.pn - 3) * 256 + bj * 128 + cw;
                        bf16_t* vp = VTA + (((size_t)b * (SEQ / 128) + (s >> 7)) * 768 + cv) * 128 + (s & 127);
#pragma unroll
                        for (int e = 0; e < 8; e += 2) { ss += v[e] * v[e] + v[e + 1] * v[e + 1]; const unsigned p = pk2(v[e], v[e + 1]); vp[e * 128] = (bf16_t)(p & 0xffffu); vp[(e + 1) * 128] = (bf16_t)(p >> 16); }
                    } else {
                        u32x4 w; w.x = pk2(v[0], v[1]); w.y = pk2(v[2], v[3]); w.z = pk2(v[4], v[5]); w.w = pk2(v[6], v[7]);
                        *(u32x4*)(QM + (size_t)row * 256 + bj * 128 + cw) = w;
                    }
                }
                if (u.pn >= 3 && u.pn < 6) { ss += __shfl_xor(ss, 16); ss += __shfl_xor(ss, 32); if (fq == 0) sq_add(vsq + row, ss); }
            }
    }
};
struct EpiProjB {
    static constexpr bool PERM = true, AFTER_DRAIN = false;
    bf16_t* P; const LAS float* rtab;
    __device__ __forceinline__ void operator()(const f32x4 (&acc)[2][2][4][2], const Unit& u, int wr, int wc, int fr_in, int fq_in) const {
        int fr = fr_in, fq = fq_in; asm volatile("" : "+v"(fr), "+v"(fq));
        const int row0 = u.pm * 256 + wr * 64 + fr, col0 = u.pn * 256 + wc * 32 + 8 * fq;
#pragma unroll
        for (int ai = 0; ai < 2; ++ai)
#pragma unroll
            for (int m = 0; m < 4; ++m) {
                const int row = row0 + ai * 128 + m * 16;
                const float rr = rtab[u.ord * 256 + (row & 255)];
#pragma unroll
                for (int bj = 0; bj < 2; ++bj) {
                    const f32x4 v0 = acc[ai][bj][m][0] * rr, v1 = acc[ai][bj][m][1] * rr;
                    u32x4 w; w.x = pk2(v0[0], v0[1]); w.y = pk2(v0[2], v0[3]); w.z = pk2(v1[0], v1[1]); w.w = pk2(v1[2], v1[3]);
                    *(u32x4*)(P + (size_t)row * DM + col0 + bj * 128) = w;
                }
            }
    }
};
struct EpiMemKV {
    static constexpr bool PERM = true, AFTER_DRAIN = false;
    bf16_t* KM; bf16_t* VMT; const sq_t* memsq;
    __device__ __forceinline__ void operator()(const f32x4 (&acc)[2][2][4][2], const Unit& u, int wr, int wc, int fr_in, int fq_in) const {
        int fr = fr_in, fq = fq_in; asm volatile("" : "+v"(fr), "+v"(fq));
        const int row0 = u.pm * 256 + wr * 64 + fr;
#pragma unroll
        for (int ai = 0; ai < 2; ++ai)
#pragma unroll
            for (int m = 0; m < 4; ++m) {
                const int row = row0 + ai * 128 + m * 16, b = row >> 8, key = row & 255;
                const float rr = __builtin_amdgcn_rsqf(sq_read(memsq + row) * (1.f / 1024.f) + EPS);
#pragma unroll
                for (int bj = 0; bj < 2; ++bj) {
                    const int c = u.pn * 256 + bj * 128 + wc * 32 + 8 * fq, l = c >> 9, cc = c & 511;
                    float v[8];
#pragma unroll
                    for (int n = 0; n < 2; ++n)
#pragma unroll
                        for (int j = 0; j < 4; ++j) v[4 * n + j] = acc[ai][bj][m][n][j] * rr;
                    if (cc < 256) {
                        const int head = cc >> 6, d = cc & 63;
                        u32x4 w; w.x = pk2(v[0], v[1]); w.y = pk2(v[2], v[3]); w.z = pk2(v[4], v[5]); w.w = pk2(v[6], v[7]);
                        *(u32x4*)(KM + ((size_t)((l * 2 + b) * 4 + head) * 256 + key) * 64 + d) = w;
                    } else {
                        const int cv = cc - 256, head = cv >> 6, d = cv & 63;
                        bf16_t* vp = VMT + (((size_t)((l * 2 + b) * 4 + head) * 4 + (key >> 6)) * 64 + d) * 64 + (key & 63);
#pragma unroll
                        for (int e = 0; e < 8; e += 2) { const unsigned p = pk2(v[e], v[e + 1]); vp[e * 64] = (bf16_t)(p & 0xffffu); vp[(e + 1) * 64] = (bf16_t)(p >> 16); }
                    }
                }
            }
    }
};


__device__ __forceinline__ void tile_load(const bf16_t* __restrict__ g, size_t gstride, u32x4 (&r)[8], int lane) {
    const bf16_t* p = g + (size_t)(lane >> 3) * gstride + 8 * (lane & 7);
#pragma unroll
    for (int i = 0; i < 8; ++i) r[i] = *(const u32x4*)(p + (size_t)(8 * i) * gstride);
}
__device__ __forceinline__ void tile_store(LAS unsigned char* t, const u32x4 (&r)[8], int lane) {
#pragma unroll
    for (int i = 0; i < 8; ++i) { const int row = 8 * i + (lane >> 3); *(LAS u32x4*)(t + row * 128 + ((((lane & 7) ^ (row >> 1)) & 7) << 4)) = r[i]; }
}
__device__ __forceinline__ bf16x8 tile_frag(const LAS unsigned char* t, int row, int chunk) { return *(const LAS bf16x8*)(t + row * 128 + (((chunk ^ (row >> 1)) & 7) << 4)); }

__device__ __forceinline__ void qtile_to_frags(const bf16_t* __restrict__ g  , size_t pitch, LAS unsigned char* img  , bf16x8 (&qf)[4], int lane) {
    u32x4 r[4];
    const bf16_t* p = g + (size_t)(lane >> 3) * pitch + 8 * (lane & 7);
#pragma unroll
    for (int i = 0; i < 4; ++i) r[i] = *(const u32x4*)(p + (size_t)(8 * i) * pitch);
#pragma unroll
    for (int i = 0; i < 4; ++i) { const int row = 8 * i + (lane >> 3); *(LAS u32x4*)(img + row * 128 + ((((lane & 7) ^ (row >> 1)) & 7) << 4)) = r[i]; }
#pragma unroll
    for (int ks = 0; ks < 4; ++ks) qf[ks] = tile_frag(img, lane & 31, 2 * ks + (lane >> 5));
}
__device__ __forceinline__ void otile_store(const f32x16& o0, const f32x16& o1, float scale, LAS unsigned char* img  , bf16_t* __restrict__ g  , int lane) {
    const int q = lane & 31, h = lane >> 5;
#pragma unroll
    for (int g4 = 0; g4 < 4; ++g4) {
        u32x2 w0, w1;
        w0.x = pk2(o0[4 * g4] * scale, o0[4 * g4 + 1] * scale); w0.y = pk2(o0[4 * g4 + 2] * scale, o0[4 * g4 + 3] * scale);
        w1.x = pk2(o1[4 * g4] * scale, o1[4 * g4 + 1] * scale); w1.y = pk2(o1[4 * g4 + 2] * scale, o1[4 * g4 + 3] * scale);
        *(LAS u32x2*)(img + q * 128 + (((g4 ^ (q >> 1)) & 7) << 4) + 8 * h) = w0;
        *(LAS u32x2*)(img + q * 128 + ((((4 + g4) ^ (q >> 1)) & 7) << 4) + 8 * h) = w1;
    }
#pragma unroll
    for (int i = 0; i < 4; ++i) { const int row = 8 * i + (lane >> 3), c = lane & 7; const u32x4 v = *(const LAS u32x4*)(img + row * 128 + (((c ^ (row >> 1)) & 7) << 4)); *(u32x4*)(g + (size_t)row * DM + 8 * c) = v; }
}

__device__ __forceinline__ void sb_attn_wave(const bf16_t* __restrict__ P, const bf16_t* __restrict__ Kb, const bf16_t* __restrict__ VTb, bf16_t* __restrict__ Y, int b, int hd, int qb, int lane, LAS unsigned char* tl  ) {
    const int q = lane & 31, h = lane >> 5;
    const int kap = 16 * ((q >> 2) & 1) + (q & 3) + 4 * (q >> 3);
    const int qpos = qb * 32 + q;
    bf16x8 qf[4];
    const bf16_t* Kh = Kb + (size_t)(b * NH + hd) * SEQ * 64;
    const bf16_t* Vh = VTb + (size_t)(b * NH + hd) * 64 * SEQ;
    LAS unsigned char* Kt = tl; LAS unsigned char* Vt = tl + 8192;
    u32x4 rk[8], rv[8];
    { const int kf = ((qb * 32 + 31) >> 6) * 64; tile_load(Kh + (size_t)kf * 64, 64, rk, lane); tile_load(Vh + (size_t)kf * 64, 64, rv, lane); }
    qtile_to_frags(P + (size_t)(b * SEQ + qb * 32) * DM + hd * 64, DM, Vt, qf, lane);
    f32x16 o0, o1;
#pragma unroll
    for (int i = 0; i < 16; ++i) { o0[i] = 0.f; o1[i] = 0.f; }
    float carry = 1.f;
    const float c1 = 0.125f * 1.4426950408889634f;
    for (int kt = (qb * 32 + 31) >> 6; kt >= 0; --kt) {
        const int k0 = kt * 64;
        tile_store(Kt, rk, lane); tile_store(Vt, rv, lane);
        if (kt > 0) { tile_load(Kh + (size_t)(k0 - 64) * 64, 64, rk, lane); tile_load(Vh + (size_t)(k0 - 64) * 64, 64, rv, lane); }
        f32x16 s0, s1;
#pragma unroll
        for (int i = 0; i < 16; ++i) { s0[i] = 0.f; s1[i] = 0.f; }
#pragma unroll
        for (int ks = 0; ks < 4; ++ks) {
            const bf16x8 a0 = tile_frag(Kt, kap, 2 * ks + h), a1 = tile_frag(Kt, 32 + kap, 2 * ks + h);
            s0 = MFMA32(a0, qf[ks], s0); s1 = MFMA32(a1, qf[ks], s1);
        }
        const int kb0 = k0 + 16 * h, kb1 = kb0 + 32;
        float T0 = 1.f, T1 = 1.f;
#pragma unroll
        for (int r = 0; r < 16; ++r) {
            { const float z = s0[r] * c1; const float t = ex2(-fabsf(z)); const float rc = rcpf_(1.f + t), tr = t * rc; const bool cz = (kb0 + r < qpos); s0[r] = cz ? (z >= 0.f ? rc : tr) : 0.f; T0 *= cz ? (z >= 0.f ? tr : rc) : 1.f; }
            { const float z = s1[r] * c1; const float t = ex2(-fabsf(z)); const float rc = rcpf_(1.f + t), tr = t * rc; const bool cz = (kb1 + r < qpos); s1[r] = cz ? (z >= 0.f ? rc : tr) : 0.f; T1 *= cz ? (z >= 0.f ? tr : rc) : 1.f; }
        }
        const float To0 = __shfl_xor(T0, 32), To1 = __shfl_xor(T1, 32);
        const float off1 = h ? 1.f : To1;
        const float off0 = h ? (To1 * T1) : (To0 * (T1 * To1));
        float run = carry * off1;
#pragma unroll
        for (int r = 15; r >= 0; --r) { const float be = s1[r]; s1[r] = be * run; run *= (1.f - be); }
        run = carry * off0;
#pragma unroll
        for (int r = 15; r >= 0; --r) { const float be = s0[r]; s0[r] = be * run; run *= (1.f - be); }
        carry *= (T0 * T1) * (To0 * To1);
#pragma unroll
        for (int s2 = 0; s2 < 2; ++s2) {
            u32x4 p0, p1;
            p0.x = pk2(s0[8 * s2 + 0], s0[8 * s2 + 1]); p0.y = pk2(s0[8 * s2 + 2], s0[8 * s2 + 3]); p0.z = pk2(s0[8 * s2 + 4], s0[8 * s2 + 5]); p0.w = pk2(s0[8 * s2 + 6], s0[8 * s2 + 7]);
            p1.x = pk2(s1[8 * s2 + 0], s1[8 * s2 + 1]); p1.y = pk2(s1[8 * s2 + 2], s1[8 * s2 + 3]); p1.z = pk2(s1[8 * s2 + 4], s1[8 * s2 + 5]); p1.w = pk2(s1[8 * s2 + 6], s1[8 * s2 + 7]);
            const bf16x8 pf0 = __builtin_bit_cast(bf16x8, p0), pf1 = __builtin_bit_cast(bf16x8, p1);
            const bf16x8 va00 = tile_frag(Vt, q, 2 * h + s2), va01 = tile_frag(Vt, 32 + q, 2 * h + s2);
            const bf16x8 va10 = tile_frag(Vt, q, 4 + 2 * h + s2), va11 = tile_frag(Vt, 32 + q, 4 + 2 * h + s2);
            o0 = MFMA32(va00, pf0, o0); o1 = MFMA32(va01, pf0, o1);
            o0 = MFMA32(va10, pf1, o0); o1 = MFMA32(va11, pf1, o1);
        }
        if (__all(carry < 1e-37f)) break;
    }
    otile_store(o0, o1, 1.f, Kt, Y + (size_t)(b * SEQ + qb * 32) * DM + hd * 64, lane);
}

__device__ __forceinline__ void mem_attn_wave(const bf16_t* __restrict__ Qrow  , int qpitch, const bf16_t* __restrict__ Km  , const bf16_t* __restrict__ Vm  ,
                                              bf16_t* __restrict__ Yrow  , int lane, LAS unsigned char* tl  ) {
    const int q = lane & 31, h = lane >> 5;
    const int kap = 16 * ((q >> 2) & 1) + (q & 3) + 4 * (q >> 3);
    bf16x8 qf[4];
    LAS unsigned char* Kt = tl; LAS unsigned char* Vt = tl + 8192;
    u32x4 rk[8], rv[8];
    tile_load(Km, 64, rk, lane); tile_load(Vm, 64, rv, lane);
    qtile_to_frags(Qrow, (size_t)qpitch, Vt, qf, lane);
    f32x16 o0, o1;
#pragma unroll
    for (int i = 0; i < 16; ++i) { o0[i] = 0.f; o1[i] = 0.f; }
    const float c1 = 0.125f * 1.4426950408889634f;
    float mrun = -3.0e38f, sum = 0.f;
#pragma unroll 1
    for (int t = 0; t < 4; ++t) {
        tile_store(Kt, rk, lane); tile_store(Vt, rv, lane);
        if (t < 3) { tile_load(Km + (size_t)(t + 1) * 64 * 64, 64, rk, lane); tile_load(Vm + (size_t)(t + 1) * 64 * 64, 64, rv, lane); }
        f32x16 s0, s1;
#pragma unroll
        for (int i = 0; i < 16; ++i) { s0[i] = 0.f; s1[i] = 0.f; }
#pragma unroll
        for (int ks = 0; ks < 4; ++ks) { s0 = MFMA32(tile_frag(Kt, kap, 2 * ks + h), qf[ks], s0); s1 = MFMA32(tile_frag(Kt, 32 + kap, 2 * ks + h), qf[ks], s1); }
        float mt = -3.0e38f;
#pragma unroll
        for (int i = 0; i < 16; ++i) mt = fmaxf(mt, fmaxf(s0[i], s1[i]));
        mt = fmaxf(mt, __shfl_xor(mt, 32));
        const float mnew = fmaxf(mrun, mt), alpha = ex2((mrun - mnew) * c1), mb = mnew * c1;
        mrun = mnew; sum *= alpha;
#pragma unroll
        for (int i = 0; i < 16; ++i) { const float p0 = ex2(s0[i] * c1 - mb), p1 = ex2(s1[i] * c1 - mb); s0[i] = p0; s1[i] = p1; sum += p0 + p1; o0[i] *= alpha; o1[i] *= alpha; }
#pragma unroll
        for (int s2 = 0; s2 < 2; ++s2) {
            u32x4 p0, p1;
            p0.x = pk2(s0[8 * s2 + 0], s0[8 * s2 + 1]); p0.y = pk2(s0[8 * s2 + 2], s0[8 * s2 + 3]); p0.z = pk2(s0[8 * s2 + 4], s0[8 * s2 + 5]); p0.w = pk2(s0[8 * s2 + 6], s0[8 * s2 + 7]);
            p1.x = pk2(s1[8 * s2 + 0], s1[8 * s2 + 1]); p1.y = pk2(s1[8 * s2 + 2], s1[8 * s2 + 3]); p1.z = pk2(s1[8 * s2 + 4], s1[8 * s2 + 5]); p1.w = pk2(s1[8 * s2 + 6], s1[8 * s2 + 7]);
            const bf16x8 pf0 = __builtin_bit_cast(bf16x8, p0), pf1 = __builtin_bit_cast(bf16x8, p1);
            o0 = MFMA32(tile_frag(Vt, q, 2 * h + s2), pf0, o0); o1 = MFMA32(tile_frag(Vt, 32 + q, 2 * h + s2), pf0, o1);
            o0 = MFMA32(tile_frag(Vt, q, 4 + 2 * h + s2), pf1, o0); o1 = MFMA32(tile_frag(Vt, 32 + q, 4 + 2 * h + s2), pf1, o1);
        }
    }
    sum += __shfl_xor(sum, 32);
    otile_store(o0, o1, 1.f / sum, Kt, Yrow, lane);
}

__device__ __forceinline__ void gmlp_wave(const float* __restrict__ Wg  , const float* __restrict__ bias  , const float* __restrict__ gain  ,
                                          const bf16_t* __restrict__ VT  , const sq_t* __restrict__ vsq  , const bf16_t* __restrict__ Ur  ,
                                          bf16_t* __restrict__ Yr  , int tblk, int lane, LAS float* rvs  , LAS unsigned char* tl  ) {
    const int q = lane & 31, h = lane >> 5;
    f32x16 X[4];
#pragma unroll
    for (int cb = 0; cb < 4; ++cb)
#pragma unroll
        for (int i = 0; i < 16; ++i) X[cb][i] = 0.f;
    const int nsh = tblk < 2 ? 1 : 2;
    u32x4 rk[8];
    tile_load(VT, 128, rk, lane);
    {
        f32x2v r; r.x = __builtin_amdgcn_rsqf(sq_read(vsq + 2 * lane) * (1.f / 768.f) + EPS); r.y = __builtin_amdgcn_rsqf(sq_read(vsq + 2 * lane + 1) * (1.f / 768.f) + EPS);
        *(LAS f32x2v*)(rvs + 2 * lane) = r; asm volatile("s_waitcnt lgkmcnt(0)" ::: "memory");
    }
    const float* wld = Wg + (32 * tblk + (lane >> 4)) * 128 + 4 * (lane & 15);
    f32x4 rw[8];
#pragma unroll
    for (int i = 0; i < 8; ++i) rw[i] = *(const f32x4*)(wld + (4 * i) * 128);
#pragma unroll 1
    for (int sh = 0; sh < nsh; ++sh) {
        bf16x8 af[4];
        {
            LAS unsigned char* wimg = tl + 8192;
#pragma unroll
            for (int i = 0; i < 8; ++i) { const int tl_ = 4 * i + (lane >> 4), rho = 2 * tl_ + ((lane >> 3) & 1); *(LAS f32x4*)(wimg + rho * 128 + ((((lane & 7) ^ tl_) & 7) << 4)) = rw[i]; }
            if (sh + 1 < nsh) {
#pragma unroll
                for (int i = 0; i < 8; ++i) rw[i] = *(const f32x4*)(wld + (4 * i) * 128 + 64 * (sh + 1));
            }
        }
#pragma unroll
        for (int k4 = 0; k4 < 4; ++k4) {
            const int ks = 4 * sh + k4;
            const LAS unsigned char* wr_ = tl + 8192 + (2 * q + (k4 >> 1)) * 128; const int c16 = 4 * (k4 & 1) + 2 * h;
            const f32x4 w0 = *(const LAS f32x4*)(wr_ + (((c16 ^ q) & 7) << 4)), w1 = *(const LAS f32x4*)(wr_ + ((((c16 + 1) ^ q) & 7) << 4));
            const f32x4 q0 = *(const LAS f32x4*)(rvs + 16 * ks + 8 * h), q1 = *(const LAS f32x4*)(rvs + 16 * ks + 8 * h + 4);
            u32x4 ap; ap.x = pk2(w0[0] * q0[0], w0[1] * q0[1]); ap.y = pk2(w0[2] * q0[2], w0[3] * q0[3]); ap.z = pk2(w1[0] * q1[0], w1[1] * q1[1]); ap.w = pk2(w1[2] * q1[2], w1[3] * q1[3]);
            af[k4] = __builtin_bit_cast(bf16x8, ap);
        }
#pragma unroll
        for (int ch = 0; ch < 2; ++ch) {
            LAS unsigned char* img = tl + ch * 8192;
            tile_store(img, rk, lane);
            if (ch == 0) tile_load(VT + 64 * 128 + 64 * sh, 128, rk, lane);
            else if (sh + 1 < nsh) tile_load(VT + 64 * (sh + 1), 128, rk, lane);
#pragma unroll
            for (int k4 = 0; k4 < 4; ++k4)
#pragma unroll
                for (int c2 = 0; c2 < 2; ++c2) X[2 * ch + c2] = MFMA32(af[k4], tile_frag(img, 32 * c2 + q, 2 * k4 + h), X[2 * ch + c2]);
        }
    }
    LAS float* mt = (LAS float*)tl;
    f32x4 bv[4];
#pragma unroll
    for (int g4 = 0; g4 < 4; ++g4) bv[g4] = *(const f32x4*)(bias + 32 * tblk + 8 * g4 + 4 * h);
#pragma unroll
    for (int cb = 0; cb < 4; ++cb) {
        const float gn = gain[32 * cb + q];
#pragma unroll
        for (int i = 0; i < 16; ++i) mt[((i & 3) + 8 * (i >> 2) + 4 * h) * 128 + 32 * cb + q] = gn * X[cb][i] + bv[i >> 2][i & 3];
    }
#pragma unroll
    for (int i8 = 0; i8 < 8; ++i8) {
        const int t = 4 * i8 + (lane >> 4), c8 = 8 * (lane & 15);
        const u32x4 uu = *(const u32x4*)(Ur + (size_t)(32 * tblk + t) * 768 + c8);
        const f32x4 m0 = *(const LAS f32x4*)(mt + t * 128 + c8), m1 = *(const LAS f32x4*)(mt + t * 128 + c8 + 4);
        u32x4 o;
        o.x = pk2(__uint_as_float(uu.x << 16) * m0[0], __uint_as_float(uu.x & 0xffff0000u) * m0[1]); o.y = pk2(__uint_as_float(uu.y << 16) * m0[2], __uint_as_float(uu.y & 0xffff0000u) * m0[3]);
        o.z = pk2(__uint_as_float(uu.z << 16) * m1[0], __uint_as_float(uu.z & 0xffff0000u) * m1[1]); o.w = pk2(__uint_as_float(uu.w << 16) * m1[2], __uint_as_float(uu.w & 0xffff0000u) * m1[3]);
        *(u32x4*)(Yr + (size_t)(32 * tblk + t) * DM + c8) = o;
    }
}

#define LDS_WAIT() asm volatile("s_waitcnt lgkmcnt(0)" ::: "memory")
struct WItem { const float* src; const float* g; bf16_t* dst; int N, K, k0, n0, drow0; bool valid; };
__device__ __forceinline__ WItem witem_decode(const cparams_t p, int it) {
    constexpr int IT_G = 16 * 88, IT_MEM = 16 * 16, IT_IN = 16 * 56, IT_OUT = 16 * 32, IT_LAYER = 6 * IT_G + IT_MEM + IT_IN + IT_OUT;
    bf16_t* Wb = (bf16_t*)(p->ws + WS_W);
    WItem w; w.g = nullptr; w.K = 1024; w.valid = true;
    if (it >= 4 * IT_LAYER) {
        const int r = it - 4 * IT_LAYER; w.N = 1536; w.k0 = 64 * (r / 48); w.n0 = 32 * (r % 48); w.drow0 = 5632 + w.n0; w.src = p->w_kv; w.g = p->kv_norm; w.dst = Wb + 2 * L_STRIDE + L_GU1;
    } else {
        const int l = it / IT_LAYER; int r = it % IT_LAYER; bf16_t* Wl = Wb + (size_t)l * L_STRIDE;
        if (r < 6 * IT_G) {
            const int j = r / IT_G, rr = r % IT_G, half = j / 3, kind = j % 3;
            if (kind < 2) {
                w.N = FF; w.k0 = 64 * (rr / 88); w.n0 = 32 * (rr % 88); w.drow0 = 256 * (w.n0 >> 7) + (w.n0 & 127) + 128 * kind;
                w.src = (half ? (kind ? p->ffn2_wu : p->ffn2_wg) : (kind ? p->ffn1_wu : p->ffn1_wg)) + (size_t)l * 1024 * FF;
                w.g = (half ? p->ffn2_norm : p->ffn1_norm) + l * 1024; w.dst = Wl + (half ? L_GU2 : L_GU1);
            } else {
                w.K = FF; w.N = 1024; w.k0 = 64 * (rr / 32); w.n0 = 32 * (rr % 32); w.drow0 = w.n0;
                w.src = (half ? p->ffn2_wd : p->ffn1_wd) + (size_t)l * FF * 1024; w.dst = Wl + (half ? L_D2 : L_D1);
            }
        } else {
            r -= 6 * IT_G;
            if (r < IT_MEM) { w.N = 512; w.k0 = 64 * (r / 16); w.n0 = 32 * (r % 16); w.drow0 = l * 512 + w.n0; w.src = p->w_mem_kv + (size_t)l * 1024 * 512; w.g = p->mem_norm; w.dst = (bf16_t*)(p->ws + WS_WMEM); }
            else {
                r -= IT_MEM;
                if (r < IT_IN) {
                    if (l < 2) { w.N = 1792; w.k0 = 64 * (r / 56); w.n0 = 32 * (r % 56); w.src = p->a_w_in + (size_t)l * 1024 * 1792; }
                    else { w.valid = r < 512; r &= 511; w.N = 1024; w.k0 = 64 * (r / 32); w.n0 = 32 * (r % 32); w.src = p->b_w_in + (size_t)(l - 2) * 1024 * 1024; }
                    w.drow0 = w.n0; w.g = p->mix_norm + l * 1024; w.dst = Wl + L_IN;
                } else {
                    r -= IT_IN; w.N = 1024; w.k0 = 64 * (r / 32); w.n0 = 32 * (r % 32); w.drow0 = w.n0;
                    w.src = (l < 2 ? p->a_w_out + (size_t)l * 1024 * 1024 : p->b_w_out + (size_t)(l - 2) * 1024 * 1024); w.dst = Wl + L_OUT;
                }
            }
        }
    }
    return w;
}
__device__ __forceinline__ void witem_load(const WItem& w, f32x4 (&v)[8], float (&gs)[8], int lane) {
    const float* sp = w.src + (size_t)(w.k0 + (lane >> 3)) * w.N + w.n0 + 4 * (lane & 7);
#pragma unroll
    for (int i = 0; i < 8; ++i) { v[i] = *(const f32x4*)(sp + (size_t)(8 * i) * w.N); gs[i] = w.g ? w.g[w.k0 + 8 * i + (lane >> 3)] : 1.f; }
}
__device__ __forceinline__ void witem_store(const WItem& w, const f32x4 (&v)[8], const float (&gs)[8], LAS float* scr, int lane) {
#pragma unroll
    for (int i = 0; i < 8; ++i) { LAS float* d = scr + (8 * i + (lane >> 3)) * 33 + 4 * (lane & 7); d[0] = v[i][0] * gs[i]; d[1] = v[i][1] * gs[i]; d[2] = v[i][2] * gs[i]; d[3] = v[i][3] * gs[i]; }
    LDS_WAIT();
    const int c = lane & 7;
#pragma unroll
    for (int j = 0; j < 4; ++j) { const int n = (lane >> 3) + 8 * j; const LAS float* s = scr + (8 * c) * 33 + n;
        u32x4 o; o.x = pk2(s[0 * 33], s[1 * 33]); o.y = pk2(s[2 * 33], s[3 * 33]); o.z = pk2(s[4 * 33], s[5 * 33]); o.w = pk2(s[6 * 33], s[7 * 33]);
        *(u32x4*)(w.dst + (size_t)(w.drow0 + n) * w.K + w.k0 + 8 * c) = o; }
    LDS_WAIT();
}

constexpr int WI_G = 16 * 88, WI_MEM = 16 * 16, WI_LAYER = 6 * WI_G + WI_MEM + 16 * 56 + 16 * 32, WI_KV = 16 * 48;
constexpr int WI_UPFRONT = WI_LAYER + 3 * WI_MEM, WI_DEFERRED = 3 * WI_LAYER + WI_KV, WI_SLICE = (WI_DEFERRED + 4) / 5;
__device__ __forceinline__ int wi_map(bool deferred, int i, bool& skip) {
    skip = false;
    if (!deferred) { if (i < WI_LAYER) return i; const int m = i - WI_LAYER; return (1 + m / WI_MEM) * WI_LAYER + 6 * WI_G + (m % WI_MEM); }
    int it;
    if (i < 2 * WI_LAYER) it = WI_LAYER + i; else if (i < 2 * WI_LAYER + WI_KV) return 4 * WI_LAYER + (i - 2 * WI_LAYER); else it = 3 * WI_LAYER + (i - 2 * WI_LAYER - WI_KV);
    const int r = it % WI_LAYER; skip = (r >= 6 * WI_G && r < 6 * WI_G + WI_MEM);
    return it;
}
__device__ __forceinline__ void convert_items(const cparams_t p, LAS float* scr, bool deferred, int lo, int hi, int w, int NW, int lane) {
    int i = lo + w; if (i >= hi) return;
    bool sk; WItem cur = witem_decode(p, wi_map(deferred, i, sk)); cur.valid = cur.valid && !sk; f32x4 v[8]; float gs[8];
    if (cur.valid) witem_load(cur, v, gs, lane);
    for (;;) {
        const int in_ = i + NW; const bool has = in_ < hi;
        WItem nx = cur; f32x4 v2[8]; float gs2[8];
        if (has) { bool sk2; nx = witem_decode(p, wi_map(deferred, in_, sk2)); nx.valid = nx.valid && !sk2; if (nx.valid) witem_load(nx, v2, gs2, lane); }
        if (cur.valid) witem_store(cur, v, gs, scr, lane);
        if (!has) break;
        cur = nx; i = in_;
#pragma unroll
        for (int k = 0; k < 8; ++k) { v[k] = v2[k]; gs[k] = gs2[k]; }
    }
}
__device__ __forceinline__ void prologue(const cparams_t p, LAS unsigned char* lds, int gw, int NGW, int wave, int lane) {
    LAS float* scr = (LAS float*)(lds + wave * 16384);
    convert_items(p, scr, false, 0, WI_UPFRONT, gw, NGW, lane);
    sq_t* rs0 = (sq_t*)(p->ws + WS_CTL + CTL_ROWSQ);
    bf16_t* XB = (bf16_t*)(p->ws + WS_XB);
    for (int m = gw; m < MROWS; m += 2 * NGW) {
        const bool two = (m + NGW) < MROWS; const int m2 = two ? m + NGW : m;
        const f32x4* xr = (const f32x4*)(p->x + (size_t)m * DM) + lane; u32x2* brow = (u32x2*)(XB + (size_t)m * DM) + lane;
        const f32x4* xr2 = (const f32x4*)(p->x + (size_t)m2 * DM) + lane; u32x2* brow2 = (u32x2*)(XB + (size_t)m2 * DM) + lane;
        f32x4 va[4], vb[4];
#pragma unroll
        for (int j = 0; j < 4; ++j) { va[j] = xr[64 * j]; vb[j] = xr2[64 * j]; }
        float ss = 0.f, ss2 = 0.f;
#pragma unroll
        for (int j = 0; j < 4; ++j) {
            u32x2 w; w.x = pk2(va[j][0], va[j][1]); w.y = pk2(va[j][2], va[j][3]); brow[64 * j] = w; ss += (va[j][0] * va[j][0] + va[j][1] * va[j][1]) + (va[j][2] * va[j][2] + va[j][3] * va[j][3]);
            u32x2 w2; w2.x = pk2(vb[j][0], vb[j][1]); w2.y = pk2(vb[j][2], vb[j][3]); if (two) brow2[64 * j] = w2; ss2 += (vb[j][0] * vb[j][0] + vb[j][1] * vb[j][1]) + (vb[j][2] * vb[j][2] + vb[j][3] * vb[j][3]);
        }
        ss = wave_sum(ss); ss2 = wave_sum(ss2);
        if (lane == 0) { rs0[m] = sq_fix(ss); if (two) rs0[m2] = sq_fix(ss2); }
    }
    sq_t* msq = (sq_t*)(p->ws + WS_CTL + CTL_MEMSQ);
    bf16_t* MB = (bf16_t*)(p->ws + WS_MEMB);
    for (int m = gw; m < BATCH * NMEM; m += NGW) {
        const f32x4* xr = (const f32x4*)(p->mem + (size_t)m * DM) + lane; u32x2* brow = (u32x2*)(MB + (size_t)m * DM) + lane;
        float ss = 0.f;
#pragma unroll
        for (int j = 0; j < 4; ++j) { const f32x4 v = xr[64 * j]; u32x2 w; w.x = pk2(v[0], v[1]); w.y = pk2(v[2], v[3]); brow[64 * j] = w; ss += (v[0] * v[0] + v[1] * v[1]) + (v[2] * v[2] + v[3] * v[3]); }
        ss = wave_sum(ss);
        if (lane == 0) msq[m] = sq_fix(ss);
    }
}

#define XB_TMO      128
#define XB_XCNT(j)  (256  + 64 * (j))
#define XB_XSUB(j)  (1280 + 64 * (j))
#define XB_XGEN(j)  (2304 + 64 * (j))
#define XB_TOP      3328
#define XB_TOPGEN   3392
#define XCD_BAR_WORDS 3456
#define XB_SPIN_CAP (1u << 18)

__device__ __forceinline__ unsigned xb_ld(unsigned* p)              { return __hip_atomic_load(p, __ATOMIC_RELAXED, __HIP_MEMORY_SCOPE_AGENT); }
__device__ __forceinline__ unsigned xb_add(unsigned* p, unsigned v) { return __hip_atomic_fetch_add(p, v, __ATOMIC_RELAXED, __HIP_MEMORY_SCOPE_AGENT); }
__device__ __forceinline__ unsigned xb_xcc_id() { return (unsigned)__builtin_amdgcn_s_getreg((3 << 11) | 20) & 0xFu; }
#define XB_SPIN(cond, bar) do { unsigned _sp = 0; while (cond) { __builtin_amdgcn_s_sleep(1); \
    if ((++_sp & 255u) == 0u) { if (xb_ld(&(bar)[XB_TMO])) break; if (_sp > XB_SPIN_CAP) { atomicAdd(&(bar)[XB_TMO], 1u); break; } } } } while (0)

struct XcdBarrier {
    unsigned* bar; unsigned x;
    volatile LAS unsigned* st;
};

__device__ __forceinline__ XcdBarrier xcd_barrier_post(unsigned* bar, volatile LAS unsigned* st) {
    XcdBarrier b; b.bar = bar; b.x = xb_xcc_id(); b.st = st;
    if (threadIdx.x == 0) (void)xb_add(&bar[XB_XCNT(b.x)], 1u);
    return b;
}
__device__ __forceinline__ void xcd_barrier_complete(unsigned* bar, unsigned x, unsigned& nloc, unsigned& nx) {
    const unsigned G = gridDim.x * gridDim.y * gridDim.z;
    unsigned sum, cnt, mine, sp = 0u;
    for (;;) {
        sum = 0u; cnt = 0u; mine = 0u;
#pragma unroll
        for (unsigned j = 0; j < 16; ++j) { const unsigned c = xb_ld(&bar[XB_XCNT(j)]); sum += c; cnt += (c > 0u) ? 1u : 0u; mine = (j == x) ? c : mine; }
        if (sum == G) break;
        __builtin_amdgcn_s_sleep(1);
        if ((++sp & 255u) == 0u) { if (xb_ld(&bar[XB_TMO])) break; if (sp > XB_SPIN_CAP) { atomicAdd(&bar[XB_TMO], 1u); break; } }
    }
    nloc = mine > 0u ? mine : 1u; nx = cnt > 0u ? cnt : 1u;
}

__device__ __forceinline__ void xcd_barrier(const XcdBarrier& b) {
    asm volatile("s_waitcnt vmcnt(0)" ::: "memory");
    __syncthreads();
    if (threadIdx.x == 0) {
        unsigned* bar = b.bar;
        __builtin_amdgcn_s_waitcnt(0);
        unsigned nloc = b.st[0], nx = b.st[1];
        if (nloc == 0u) { xcd_barrier_complete(bar, b.x, nloc, nx); b.st[0] = nloc; b.st[1] = nx; }
        const unsigned old = xb_add(&bar[XB_XSUB(b.x)], 1u);
        const unsigned gen = old / nloc;
        if (old + 1u == (gen + 1u) * nloc) {
            __builtin_amdgcn_fence(__ATOMIC_RELEASE, "agent");
            asm volatile("s_waitcnt vmcnt(0)" ::: "memory");
            const unsigned og = xb_add(&bar[XB_TOP], 1u);
            const unsigned tg = og / nx;
            if (og + 1u == (tg + 1u) * nx) xb_add(&bar[XB_TOPGEN], 1u);
            else XB_SPIN(xb_ld(&bar[XB_TOPGEN]) == tg, bar);
            __builtin_amdgcn_fence(__ATOMIC_ACQUIRE, "agent");
            xb_add(&bar[XB_XGEN(b.x)], 1u);
            asm volatile("s_waitcnt vmcnt(0)" ::: "memory");
        } else {
            XB_SPIN(xb_ld(&bar[XB_XGEN(b.x)]) == gen, bar);
            __builtin_amdgcn_fence(__ATOMIC_ACQUIRE, "agent");
            asm volatile("s_waitcnt vmcnt(0)" ::: "memory");
        }
    }
    __syncthreads();
}
struct MemOrder {
    int G, c;
    __device__ bool next(int i, Unit& u) const { const int L = i * G + c; if (L >= 16) return false; u.pm = L & 1; u.pn = L >> 1; u.ord = i; return true; }
    __device__ __forceinline__ void a_ready(const Unit&) const {}
    __device__ __forceinline__ void done(const Unit&) const {}
};
constexpr int RTAB_OFF = 136192;
template <class Sched> __device__ __forceinline__ void fill_rtab(LAS unsigned char* lds, const Sched& S, const sq_t* rowsq, int wave_id) {
    const int tid = wave_id * 64 + lane_id_opaque();
    LAS float* rt = (LAS float*)(lds + RTAB_OFF);
#pragma unroll 1
    for (int i = 0; i < 8; ++i) {
        Unit u; if (!S.next(i, u)) break;
        if ((tid >> 8) == (i & 1)) rt[i * 256 + (tid & 255)] = __builtin_amdgcn_rsqf(sq_read(rowsq + u.pm * 256 + (tid & 255)) * (1.f / 1024.f) + EPS);
    }
    __syncthreads();
}
#define GRID_SYNC() _Pragma("unroll 1") for (int rs_ = 0; rs_ < REP_SYNC; ++rs_) xcd_barrier(xbar)
#define GRID_SYNC_CG() do { asm volatile("s_waitcnt vmcnt(0) lgkmcnt(0)" ::: "memory"); __syncthreads(); grid.sync(); __builtin_amdgcn_fence(__ATOMIC_ACQUIRE, "agent"); asm volatile("s_waitcnt vmcnt(0)" ::: "memory"); __syncthreads(); } while (0)
__global__ void __launch_bounds__(NWAVES * 64, 2) yoco_fwd(Params p_args_in_kernarg_segment) {
    extern __shared__ __attribute__((aligned(16))) unsigned char lds_raw[];
    LAS unsigned char* lds = (LAS unsigned char*)lds_raw;
    cg::grid_group grid = cg::this_grid();
    const int wave = __builtin_amdgcn_readfirstlane((int)threadIdx.x >> 6);
    const int G = gridDim.x, bx = blockIdx.x;
    const int gw = bx * NWAVES + wave, NGW = G * NWAVES;
    if (threadIdx.x < 16) ((LAS unsigned*)(lds + 131072))[threadIdx.x] = 0u;
    __syncthreads();
    const XcdBarrier xbar = xcd_barrier_post((unsigned*)(kparams()->ws + WS_CTL + CTL_BAR), (volatile LAS unsigned*)(lds + 131072));
    grid.sync();
#pragma unroll 1
    for (int rp = 0; rp < REP_PRO; ++rp) prologue(kparams(), lds, gw, NGW, wave, lane_id_opaque());
    GRID_SYNC();

#pragma unroll 1
    for (int ph = 0; ph < 28; ++ph) {
        const int l = ph / 7, t = ph % 7;
        const int lane = lane_id_opaque();
        const cparams_t p = kparams(); unsigned char* ws = p->ws;
        sq_t* rowsq = (sq_t*)(ws + WS_CTL + CTL_ROWSQ);
        sq_t* vsqb = (sq_t*)(ws + WS_CTL + CTL_VSQ);
        const sq_t* memsq = (const sq_t*)(ws + WS_CTL + CTL_MEMSQ);
        bf16_t* Wb = (bf16_t*)(ws + WS_W);
        bf16_t* XB = (bf16_t*)(ws + WS_XB);
        bf16_t* Hb = (bf16_t*)(ws + WS_H);
        bf16_t* Ub = (bf16_t*)(ws + WS_U); bf16_t* VTA = (bf16_t*)(ws + WS_VTA); bf16_t* QM = (bf16_t*)(ws + WS_QM); bf16_t* Pb = (bf16_t*)(ws + WS_P); bf16_t* Yb = (bf16_t*)(ws + WS_Y);
        bf16_t* Kb = (bf16_t*)(ws + WS_K); bf16_t* VTb = (bf16_t*)(ws + WS_VT);
        bf16_t* MB = (bf16_t*)(ws + WS_MEMB); bf16_t* KM = (bf16_t*)(ws + WS_KMEM); bf16_t* VMT = (bf16_t*)(ws + WS_VMEMT);
        bf16_t* Wl = Wb + (size_t)l * L_STRIDE;
        if (t == 0 || t == 5) {
            const bool kv = (t == 0 && l == 2);
            const int N = kv ? 7168 : 5632;
            const int slice = kv ? -1 : (l == 0 ? (t == 0 ? 0 : 1) : l == 1 ? (t == 0 ? 2 : 3) : (l == 2 ? 4 : -1));
            const int GG = (slice >= 0 && G >= 64) ? G - 16 : G;
            if (bx >= GG) {
                convert_items(p, (LAS float*)(lds + wave * 16384), true, slice * WI_SLICE, (slice + 1) * WI_SLICE < WI_DEFERRED ? (slice + 1) * WI_SLICE : WI_DEFERRED, (bx - GG) * NWAVES + wave, 16 * NWAVES, lane);
            } else {
                pg8::Gemm g{XB, Wl + (t == 0 ? L_GU1 : L_GU2), MROWS, N, 1024}; pg8::StaticOrder S; S.init(MROWS, N, GG, bx);
                fill_rtab(lds, S, rowsq + (size_t)(3 * l + (t == 0 ? 0 : 2)) * MROWS, wave);
                EpiSwiGLU E{Hb, (const LAS float*)(lds + RTAB_OFF), Kb, VTb};
#pragma unroll 1
                for (int rp = 0; rp < REP_GU; ++rp) pg8::gemm_phase<EpiSwiGLU, pg8::StaticOrder, true, true>(lds, g, S, E, wave);
                if (ph == 0) {
                    pg8::Gemm gm{MB, (const bf16_t*)(ws + WS_WMEM), BATCH * NMEM, 2048, 1024}; MemOrder SM{GG, (bx + 16) % GG};
                    EpiMemKV EM{KM, VMT, memsq};
                    pg8::gemm_phase<EpiMemKV, MemOrder, true, true>(lds, gm, SM, EM, wave);
                }
            }
        } else if (t == 1 || t == 4 || t == 6) {
            const bool outp = (t == 4);
            pg8::Gemm g{outp ? Yb : Hb, Wl + (t == 1 ? L_D1 : (t == 4 ? L_OUT : L_D2)), MROWS, 1024, outp ? 1024 : FF}; pg8::StaticOrder S; S.init(MROWS, 1024, G, bx);
            EpiResid E{XB, rowsq + (size_t)(3 * l + (t == 1 ? 1 : (t == 4 ? 2 : 3))) * MROWS, outp ? 1.0f : 0.5f};
            pg8::gemm_phase<EpiResid, pg8::StaticOrder, true, true>(lds, g, S, E, wave);
        } else if (t == 2) {
            const sq_t* rs = rowsq + (size_t)(3 * l + 1) * MROWS;
            if (l < 2) {
                pg8::Gemm g{XB, Wl + L_IN, MROWS, 1792, 1024}; pg8::StaticOrder S; S.init(MROWS, 1792, G, bx);
                fill_rtab(lds, S, rs, wave);
                EpiProjA E{Ub, VTA, QM, (const LAS float*)(lds + RTAB_OFF), vsqb + (size_t)l * MROWS};
#pragma unroll 1
                for (int rp = 0; rp < REP_IN; ++rp) pg8::gemm_phase<EpiProjA, pg8::StaticOrder, true, true>(lds, g, S, E, wave);
            } else {
                pg8::Gemm g{XB, Wl + L_IN, MROWS, 1024, 1024}; pg8::StaticOrder S; S.init(MROWS, 1024, G, bx);
                fill_rtab(lds, S, rs, wave);
                EpiProjB E{Pb, (const LAS float*)(lds + RTAB_OFF)};
#pragma unroll 1
                for (int rp = 0; rp < REP_IN; ++rp) pg8::gemm_phase<EpiProjB, pg8::StaticOrder, true, true>(lds, g, S, E, wave);
                asm volatile("s_waitcnt vmcnt(0)" ::: "memory"); __syncthreads();
                __builtin_amdgcn_fence(__ATOMIC_ACQUIRE, "agent"); asm volatile("s_waitcnt vmcnt(0)" ::: "memory");
#pragma unroll 1
                for (int i = 0; ; ++i) {
                    pg8::Unit u; if (!S.next(i, u)) break;
                    const int b = u.pm >> 5, qb0 = (u.pm & 31) * 8;
#pragma unroll 1
                    for (int e = wave; e < 32; e += NWAVES) {
                        const int lane2 = lane_id_opaque(); const int j = e >> 3, qb = qb0 + (e & 7), row0 = b * SEQ + qb * 32;
                        if (u.pn < 3) sb_attn_wave(Pb, Kb, VTb, Yb, b, 4 * u.pn + j, qb, lane2, lds + wave * 16384);
                        else mem_attn_wave(Pb + (size_t)row0 * DM + 768 + j * 64, DM, KM + (size_t)((l * 2 + b) * 4 + j) * 256 * 64, VMT + (size_t)((l * 2 + b) * 4 + j) * 64 * 256,
                                           Yb + (size_t)row0 * DM + 768 + j * 64, lane2, lds + wave * 16384);
                    }
                }
            }
        } else {
#pragma unroll 1
          for (int rp = 0; rp < REP_MIX; ++rp) {
            if (l < 2) {
                constexpr int NU_G = 128 * 6 * 4, NU = NU_G + 2048;
                for (int u = gw; u < NU; u += NGW) {
                    const int lane = lane_id_opaque();
                    if (u < NU_G) {
                        const int w = u / 24, rem = u % 24, g = rem >> 2, tblk = rem & 3, b = w >> 6, s0 = (w & 63) * 128, row0 = b * SEQ + s0;
                        gmlp_wave(p->a_w_sp + (size_t)(l * 6 + g) * 16384, p->a_b_sp + (l * 6 + g) * 128, p->a_v_norm + l * 768 + g * 128,
                                  VTA + (((size_t)b * (SEQ / 128) + (w & 63)) * 768 + g * 128) * 128, vsqb + (size_t)l * MROWS + row0, Ub + (size_t)row0 * 768 + g * 128, Yb + (size_t)row0 * DM + g * 128, tblk, lane, (LAS float*)(lds + 132096 + wave * 512), lds + wave * 16384);
                    } else {
                        const int v = u - NU_G, qb = v & 255, head = (v >> 8) & 3, b = v >> 10, row0 = b * SEQ + qb * 32;
                        mem_attn_wave(QM + (size_t)row0 * 256 + head * 64, 256, KM + (size_t)((l * 2 + b) * 4 + head) * 256 * 64, VMT + (size_t)((l * 2 + b) * 4 + head) * 64 * 256,
                                      Yb + (size_t)row0 * DM + 768 + head * 64, lane, lds + wave * 16384);
                    }
                }
            }
          }
        }
        if (t == 2 && l >= 2) continue;
        GRID_SYNC();
    }
    {
        const cparams_t p = kparams(); const sq_t* rs = (const sq_t*)(p->ws + WS_CTL + CTL_ROWSQ) + (size_t)12 * MROWS; const int lane = lane_id_opaque();
        const f32x4* gr = (const f32x4*)p->final_norm + lane;
        f32x4 gv[4];
#pragma unroll
        for (int j = 0; j < 4; ++j) gv[j] = gr[64 * j];
        const bf16_t* XBf = (const bf16_t*)(p->ws + WS_XB);
        for (int m = gw; m < MROWS; m += 2 * NGW) {
            const bool two = (m + NGW) < MROWS; const int m2 = two ? m + NGW : m;
            const float r0 = __builtin_amdgcn_rsqf(sq_read(rs + m) * (1.f / 1024.f) + EPS), r1 = __builtin_amdgcn_rsqf(sq_read(rs + m2) * (1.f / 1024.f) + EPS);
            const u32x2* x0 = (const u32x2*)(XBf + (size_t)m * DM) + lane; const u32x2* x1 = (const u32x2*)(XBf + (size_t)m2 * DM) + lane;
            f32x4* o0 = (f32x4*)(p->out + (size_t)m * DM) + lane; f32x4* o1 = (f32x4*)(p->out + (size_t)m2 * DM) + lane;
            u32x2 a[4], b[4];
#pragma unroll
            for (int j = 0; j < 4; ++j) { a[j] = x0[64 * j]; b[j] = x1[64 * j]; }
#pragma unroll
            for (int j = 0; j < 4; ++j) {
                const f32x4 av = {__uint_as_float(a[j].x << 16), __uint_as_float(a[j].x & 0xffff0000u), __uint_as_float(a[j].y << 16), __uint_as_float(a[j].y & 0xffff0000u)};
                const f32x4 bv = {__uint_as_float(b[j].x << 16), __uint_as_float(b[j].x & 0xffff0000u), __uint_as_float(b[j].y << 16), __uint_as_float(b[j].y & 0xffff0000u)};
                o0[64 * j] = av * r0 * gv[j]; if (two) o1[64 * j] = bv * r1 * gv[j];
            }
        }
    }
}

extern "C" void kernel_launch(void* const* d_in, const int* in_sizes, int n_in, void* d_out, int out_size, void* d_ws, size_t ws_size, hipStream_t stream) {
    static int grid = 0;
    if (grid == 0) {
        if (n_in != 23 || in_sizes[0] != MROWS * DM || out_size != MROWS * DM || ws_size < WS_END) {
            fprintf(stderr, "kernel_launch: unexpected problem (n_in %d, in0 %d, out %d, ws %zu; need ws >= %zu)\n", n_in, n_in > 0 ? in_sizes[0] : -1, out_size, ws_size, (size_t)WS_END); grid = -1; return; }
        int dev = 0, cus = 0, per_cu = 0;
        (void)hipGetDevice(&dev); (void)hipDeviceGetAttribute(&cus, hipDeviceAttributeMultiprocessorCount, dev);
        if (hipFuncSetAttribute((const void*)yoco_fwd, hipFuncAttributeMaxDynamicSharedMemorySize, LDS_BYTES) != hipSuccess) { fprintf(stderr, "kernel_launch: hipFuncSetAttribute failed\n"); grid = -1; return; }
        if (hipOccupancyMaxActiveBlocksPerMultiprocessor(&per_cu, (const void*)yoco_fwd, NWAVES * 64, LDS_BYTES) != hipSuccess || per_cu < 1) { fprintf(stderr, "kernel_launch: occupancy query failed (%d)\n", per_cu); per_cu = 1; }
        (void)hipGetLastError();
        grid = cus * 1;
        if (grid <= 0) grid = 256;
    }
    if (grid < 0) return;
    (void)hipMemsetAsync((char*)d_ws + WS_CTL, 0, CTL_BYTES, stream);
    Params p{};
    const float** pp = (const float**)&p;
    for (int i = 0; i < 23; ++i) pp[i] = (const float*)d_in[i];
    p.out = (float*)d_out; p.ws = (unsigned char*)d_ws;
    void* args[] = {&p};
    hipError_t e = hipLaunchCooperativeKernel((const void*)yoco_fwd, dim3(grid), dim3(NWAVES * 64), args, LDS_BYTES, stream);
    if (e != hipSuccess) fprintf(stderr, "kernel_launch: cooperative launch failed: %s (grid %d)\n", hipGetErrorString(e), grid);
}
```

```cpp
#include <hip/hip_runtime.h>
#include <hip/hip_cooperative_groups.h>
#include <cstdio>
#include <cstdint>
namespace cg = cooperative_groups;
__device__ __forceinline__ int lane_id_opaque() { int l = __builtin_amdgcn_mbcnt_hi(~0u, __builtin_amdgcn_mbcnt_lo(~0u, 0u)); asm volatile("" : "+v"(l)); return l; }
namespace pg8 {
#define PG8_LAS __attribute__((address_space(3)))
typedef unsigned short bf16_t;
typedef short bf16x8 __attribute__((ext_vector_type(8)));
typedef float f32x4 __attribute__((ext_vector_type(4)));
typedef unsigned u32x4 __attribute__((ext_vector_type(4)));
constexpr int BM = 256, BK = 64, HALF = 128, HTB = HALF * BK * 2  , STAGE_BYTES = 8 * HTB, NXCD = 8, WGM = 8;

__host__ __device__ __forceinline__ int lds_byte(int r, int c) { const int st = (r >> 4) * 2 + (c >> 5), rr = r & 15, cc = c & 31, ob = rr * 64 + cc * 2; return st * 1024 + (ob ^ (((ob >> 9) & 1) << 5)); }
__host__ __device__ __forceinline__ void stage_rc(int b, int& R, int& C) { const int st = b / 1024, sb = b % 1024, swz = sb ^ (((sb >> 9) & 1) << 5); R = (st >> 1) * 16 + swz / 64; C = (st & 1) * 32 + (swz % 64) / 2; }
__host__ __device__ __forceinline__ int perm32(int rho) { const int n = rho >> 4, i = rho & 15; return 8 * (i >> 2) + 4 * n + (i & 3); }

struct Unit { int pm, pn, ord; };
struct Gemm { const bf16_t* A; const bf16_t* Bt; int M, N, K; };

struct StaticOrder {
    int nM, nN, nwg, G, c;
    __host__ __device__ void init(int M, int N, int G_, int c_) { nM = M / BM; nN = N / BM; nwg = nM * nN; G = G_; c = c_; }
    __host__ __device__ bool next(int i, Unit& u) const {
        const long L = (long)i * G + c; if (L >= nwg) return false;
        int wgid = (int)L; { const int q = nwg / NXCD, r = nwg % NXCD, xcd = wgid % NXCD, off = wgid / NXCD; wgid = (xcd < r ? xcd * (q + 1) : r * (q + 1) + (xcd - r) * q) + off; }
        const int nig = WGM * nN, gid = wgid / nig, fm = gid * WGM, gsz = (nM - fm) < WGM ? (nM - fm) : WGM;
        u.pm = fm + ((wgid % nig) % gsz); u.pn = (wgid % nig) / gsz; u.ord = i; return true;
    }
    __device__ __forceinline__ void a_ready(const Unit&) const {}
    __device__ __forceinline__ void done(const Unit&) const {}
};

__device__ __forceinline__ unsigned cvt_pk_bf16(float lo, float hi) { unsigned r; asm volatile("v_cvt_pk_bf16_f32 %0, %1, %2" : "=v"(r) : "v"(lo), "v"(hi)); return r; }
typedef float f32x2 __attribute__((ext_vector_type(2)));
template <class Epi, class Sched, bool ALIGN_EPI = false, bool SP2 = false>
__device__ __forceinline__ void gemm_phase(PG8_LAS unsigned char* lds, const Gemm g, const Sched& S, const Epi& E, const int wave_id) {
    const int tid_ = wave_id * 64 + lane_id_opaque();
    const int tid = tid_, wid = __builtin_amdgcn_readfirstlane(tid >> 6), lane = tid & 63, wr = wid >> 2, wc = wid & 3, fr = lane & 15, fq = lane >> 4;
    const int K = g.K, nt = K / BK;
    unsigned voffA[2], voffB[2];
#pragma unroll
    for (int i = 0; i < 2; ++i) { int R, C; stage_rc(tid * 16 + i * 8192, R, C); const int Rb = Epi::PERM ? ((R & ~31) + perm32(R & 31)) : R;
        voffA[i] = (unsigned)(R * K + C) * 2u; voffB[i] = (unsigned)(Rb * K + C) * 2u; }
    const size_t kstep = (size_t)(BK * 2);
    const size_t hstep = (size_t)HALF * K * 2;
    const size_t tstep = 2 * hstep;
    const unsigned ldsw = (unsigned)wid * 1024u;
    const int aoff = lds_byte(wr * 64 + fr, fq * 8), boff = lds_byte(wc * 32 + fr, fq * 8);
#define PG8_SA(b, h) (((b) * 2 + (h)) * HTB)
#define PG8_SB(b, h) ((4 + (b) * 2 + (h)) * HTB)
#define PG8_STAGE(bufoff, gbase, voff) do { _Pragma("unroll") for (int _i = 0; _i < 2; ++_i) \
        __builtin_amdgcn_global_load_lds((const unsigned*)((const char*)(gbase) + (voff)[_i]), (PG8_LAS unsigned*)(lds + (bufoff) + ldsw + _i * 8192), 16, 0, 0); } while (0)
#define PG8_LDA(dst, b, h) do { _Pragma("unroll") for (int m = 0; m < 4; ++m) _Pragma("unroll") for (int k = 0; k < 2; ++k) dst[m][k] = *(const PG8_LAS bf16x8*)(lds + PG8_SA(b, h) + aoff + m * 2048 + k * 1024); } while (0)
#define PG8_LDB(dst, b, h) do { _Pragma("unroll") for (int n = 0; n < 2; ++n) _Pragma("unroll") for (int k = 0; k < 2; ++k) dst[n][k] = *(const PG8_LAS bf16x8*)(lds + PG8_SB(b, h) + boff + n * 2048 + k * 1024); } while (0)
#define PG8_MMA(ai, bj, At, Bt) do { __builtin_amdgcn_s_setprio(1); _Pragma("unroll") for (int m = 0; m < 4; ++m) _Pragma("unroll") for (int n = 0; n < 2; ++n) _Pragma("unroll") for (int k = 0; k < 2; ++k) \
        acc[ai][bj][m][n] = __builtin_amdgcn_mfma_f32_16x16x32_bf16(Bt[n][k], At[m][k], acc[ai][bj][m][n], 0, 0, 0); __builtin_amdgcn_s_setprio(0); } while (0)
#define PG8_WAIT_V(n) asm volatile("s_waitcnt vmcnt(" #n ")" ::: "memory")
#define PG8_WAIT_L(n) asm volatile("s_waitcnt lgkmcnt(" #n ")" ::: "memory")
#define PG8_BAR __builtin_amdgcn_s_barrier()
#define PG8_SCHED __builtin_amdgcn_sched_barrier(0)
    Unit cur, nxt; int ui = 0;
    if (!S.next(0, cur)) return;
    f32x4 acc[2][2][4][2];
#pragma unroll
    for (int a = 0; a < 2; ++a)
#pragma unroll
        for (int b = 0; b < 2; ++b)
#pragma unroll
            for (int m = 0; m < 4; ++m)
#pragma unroll
                for (int n = 0; n < 2; ++n) acc[a][b][m][n] = (f32x4){0.f, 0.f, 0.f, 0.f};
    bf16x8 At[4][2], B0[2][2], B1[2][2];
    const char* cA = (const char*)g.A + (size_t)cur.pm * tstep; const char* cB = (const char*)g.Bt + (size_t)cur.pn * tstep;
    S.a_ready(cur);
    if constexpr (SP2) {
        PG8_STAGE(PG8_SB(0, 0), cB, voffB); PG8_STAGE(PG8_SB(0, 1), cB + hstep, voffB); PG8_STAGE(PG8_SA(0, 0), cA, voffA); PG8_STAGE(PG8_SA(0, 1), cA + hstep, voffA);
        if (wr == 1) PG8_BAR;
        PG8_WAIT_V(2); PG8_BAR;
        PG8_STAGE(PG8_SB(1, 0), cB + kstep, voffB); PG8_STAGE(PG8_SA(1, 0), cA + kstep, voffA); PG8_STAGE(PG8_SB(1, 1), cB + hstep + kstep, voffB);
        PG8_WAIT_V(6); PG8_BAR;
    } else {
        PG8_STAGE(PG8_SB(0, 0), cB, voffB); PG8_STAGE(PG8_SA(0, 0), cA, voffA); PG8_STAGE(PG8_SB(0, 1), cB + hstep, voffB); PG8_STAGE(PG8_SA(0, 1), cA + hstep, voffA);
        if (wr == 1) PG8_BAR;
        PG8_WAIT_V(4); PG8_BAR;
        PG8_STAGE(PG8_SB(1, 0), cB + kstep, voffB); PG8_STAGE(PG8_SA(1, 0), cA + kstep, voffA); PG8_STAGE(PG8_SB(1, 1), cB + hstep + kstep, voffB);
        PG8_WAIT_V(6); PG8_BAR;
    }
    for (;;) {
        const bool has_next = S.next(ui + 1, nxt);
        const char* nA = has_next ? (const char*)g.A + (size_t)nxt.pm * tstep : cA; const char* nB = has_next ? (const char*)g.Bt + (size_t)nxt.pn * tstep : cB;
        for (int t = 0; t < nt; t += 2) {
            const bool last = (t == nt - 2);
            const char* a1 = cA + (size_t)(t + 1) * kstep;
            const char* a2 = last ? nA : cA + (size_t)(t + 2) * kstep; const char* b2 = last ? nB : cB + (size_t)(t + 2) * kstep;
            const char* a3 = a2 + kstep; const char* b3 = b2 + kstep;
            if (last && has_next) S.a_ready(nxt);
            if constexpr (SP2) {
            PG8_LDB(B0, 0, 0); PG8_LDB(B1, 0, 1); PG8_SCHED; PG8_LDA(At, 0, 0); PG8_STAGE(PG8_SA(1, 1), a1 + hstep, voffA);
            PG8_WAIT_V(8); PG8_WAIT_L(0); PG8_BAR; PG8_MMA(0, 0, At, B0); PG8_MMA(0, 1, At, B1); PG8_BAR; PG8_SCHED;
            PG8_LDA(At, 0, 1); PG8_STAGE(PG8_SB(0, 0), b2, voffB); PG8_STAGE(PG8_SB(0, 1), b2 + hstep, voffB); PG8_STAGE(PG8_SA(0, 0), a2, voffA);
            PG8_WAIT_V(8); PG8_WAIT_L(0); PG8_BAR; PG8_MMA(1, 0, At, B0); PG8_MMA(1, 1, At, B1); PG8_BAR; PG8_SCHED;
            PG8_LDB(B0, 1, 0); PG8_LDB(B1, 1, 1); PG8_SCHED; PG8_LDA(At, 1, 0); PG8_STAGE(PG8_SA(0, 1), a2 + hstep, voffA);
            PG8_WAIT_V(8); PG8_WAIT_L(0); PG8_BAR; PG8_MMA(0, 0, At, B0); PG8_MMA(0, 1, At, B1); PG8_BAR; PG8_SCHED;
            PG8_LDA(At, 1, 1); PG8_STAGE(PG8_SB(1, 0), b3, voffB); PG8_STAGE(PG8_SB(1, 1), b3 + hstep, voffB); PG8_STAGE(PG8_SA(1, 0), a3, voffA);
            PG8_WAIT_V(8); PG8_WAIT_L(0); PG8_BAR; PG8_MMA(1, 0, At, B0); PG8_MMA(1, 1, At, B1); PG8_BAR; PG8_SCHED;
            } else {
            PG8_LDB(B0, 0, 0); PG8_SCHED; PG8_LDA(At, 0, 0); PG8_STAGE(PG8_SA(1, 1), a1 + hstep, voffA);
            PG8_WAIT_L(8); PG8_BAR; PG8_WAIT_L(0); PG8_MMA(0, 0, At, B0); PG8_BAR; PG8_SCHED;
            PG8_LDB(B1, 0, 1); PG8_STAGE(PG8_SB(0, 0), b2, voffB);
            PG8_BAR; PG8_WAIT_L(0); PG8_MMA(0, 1, At, B1); PG8_BAR;
            PG8_LDA(At, 0, 1); PG8_STAGE(PG8_SA(0, 0), a2, voffA);
            PG8_BAR; PG8_WAIT_L(0); PG8_MMA(1, 0, At, B0); PG8_BAR; PG8_SCHED;
            PG8_STAGE(PG8_SB(0, 1), b2 + hstep, voffB);
            PG8_WAIT_V(6); PG8_BAR; PG8_MMA(1, 1, At, B1); PG8_BAR;
            PG8_LDB(B0, 1, 0); PG8_SCHED; PG8_LDA(At, 1, 0); PG8_STAGE(PG8_SA(0, 1), a2 + hstep, voffA);
            PG8_WAIT_L(8); PG8_BAR; PG8_WAIT_L(0); PG8_MMA(0, 0, At, B0); PG8_BAR; PG8_SCHED;
            PG8_LDB(B1, 1, 1); PG8_STAGE(PG8_SB(1, 0), b3, voffB);
            PG8_BAR; PG8_WAIT_L(0); PG8_MMA(0, 1, At, B1); PG8_BAR;
            PG8_LDA(At, 1, 1); PG8_STAGE(PG8_SA(1, 0), a3, voffA);
            PG8_BAR; PG8_WAIT_L(0); PG8_MMA(1, 0, At, B0); PG8_BAR; PG8_SCHED;
            PG8_STAGE(PG8_SB(1, 1), b3 + hstep, voffB);
            PG8_WAIT_V(6); PG8_BAR; PG8_MMA(1, 1, At, B1); PG8_BAR;
            }
        }
        if constexpr (ALIGN_EPI) { if (wr == 0) PG8_BAR; }
        if constexpr (!Epi::AFTER_DRAIN) { E(acc, cur, wr, wc, fr, fq); S.done(cur); }
        if (!has_next) break;
#pragma unroll
        for (int a = 0; a < 2; ++a)
#pragma unroll
            for (int b = 0; b < 2; ++b)
#pragma unroll
                for (int m = 0; m < 4; ++m)
#pragma unroll
                    for (int n = 0; n < 2; ++n) acc[a][b][m][n] = (f32x4){0.f, 0.f, 0.f, 0.f};
        cur = nxt; cA = nA; cB = nB; ++ui;
        if constexpr (ALIGN_EPI) { if (wr == 1) PG8_BAR; }
    }
    PG8_WAIT_V(0);
    if constexpr (!ALIGN_EPI) { if (wr == 0) PG8_BAR; }
    PG8_BAR;
    if constexpr (Epi::AFTER_DRAIN) { E.fused(acc, cur, wr, wc, fr, fq, lds, wid, lane); S.done(cur); }
#undef PG8_SA
#undef PG8_SB
#undef PG8_STAGE
#undef PG8_LDA
#undef PG8_LDB
#undef PG8_MMA
#undef PG8_WAIT_V
#undef PG8_WAIT_L
#undef PG8_BAR
#undef PG8_SCHED
}
}

using pg8::bf16_t; using pg8::f32x4; using pg8::u32x4; using pg8::Unit;
typedef short bf16x8 __attribute__((ext_vector_type(8)));
typedef float f32x16 __attribute__((ext_vector_type(16)));
typedef float f32x2v __attribute__((ext_vector_type(2)));
typedef __bf16 bf16v2 __attribute__((ext_vector_type(2)));
typedef unsigned u32x2 __attribute__((ext_vector_type(2)));
#define LAS __attribute__((address_space(3)))
#define MFMA32(a, b, c) __builtin_amdgcn_mfma_f32_32x32x16_bf16((a), (b), (c), 0, 0, 0)

constexpr int BATCH = 2, SEQ = 8192, DM = 1024, MROWS = BATCH * SEQ, FF = 2816, NMEM = 256, NH = 12;
constexpr float EPS = 1e-6f;
constexpr int NWAVES = 8;

constexpr size_t MiB = 1u << 20;
constexpr size_t WS_CTL = 0, CTL_BYTES = 3 * MiB;
constexpr size_t CTL_ROWSQ = 0;
constexpr size_t CTL_VSQ = 13 * 16384 * 8;
constexpr size_t CTL_MEMSQ = CTL_VSQ + 2 * 16384 * 8;
constexpr size_t CTL_BAR = 2 * MiB;
static_assert(CTL_MEMSQ + 4096 <= CTL_BAR && CTL_BAR + 16384 <= CTL_BYTES, "ctl");
constexpr size_t E_GU = 5632ull * 1024, E_D = 1024ull * 2816, E_INA = 1792ull * 1024, E_OUT = 1024ull * 1024;
constexpr size_t L_GU1 = 0, L_D1 = 7168ull * 1024, L_GU2 = L_D1 + E_D, L_D2 = L_GU2 + E_GU, L_IN = L_D2 + E_D, L_OUT = L_IN + E_INA, L_STRIDE = L_OUT + E_OUT;
constexpr size_t WS_W = 3 * MiB;
constexpr size_t WS_WMEM = WS_W + 4 * L_STRIDE * 2;
constexpr size_t WS_XB = 174 * MiB;
static_assert(WS_WMEM + 2048ull * 1024 * 2 <= WS_XB, "weights region");
constexpr size_t WS_H = 206 * MiB;
constexpr size_t WS_U = WS_H, WS_VTA = WS_H + 24 * MiB, WS_QM = WS_H + 48 * MiB, WS_P = WS_H, WS_Y = WS_H + 56 * MiB;
constexpr size_t WS_K = 294 * MiB, WS_VT = 318 * MiB;
constexpr size_t WS_MEMB = 342 * MiB, WS_KMEM = 343 * MiB, WS_VMEMT = 344 * MiB, WS_END = 345 * MiB;
constexpr int LDS_BYTES = 147456;
#define REP_PRO 1
#define REP_SYNC 1
#define REP_MIX 1
#define REP_GU 1
#define REP_IN 1


struct Params {
    const float *x, *mem, *ffn1_norm, *ffn1_wg, *ffn1_wu, *ffn1_wd, *mix_norm, *ffn2_norm, *ffn2_wg, *ffn2_wu, *ffn2_wd, *mem_norm, *w_mem_kv,
                *a_w_in, *a_v_norm, *a_w_sp, *a_b_sp, *a_w_out, *kv_norm, *w_kv, *b_w_in, *b_w_out, *final_norm;
    float* out; unsigned char* ws;
};

typedef const Params __attribute__((address_space(4)))* cparams_t;
__device__ __forceinline__ cparams_t kparams() { cparams_t k = (cparams_t)__builtin_amdgcn_kernarg_segment_ptr(); asm volatile("" : "+s"(k)); return k; }
__device__ __forceinline__ unsigned pk2(float a, float b) { bf16v2 v = __builtin_convertvector((f32x2v){a, b}, bf16v2); return __builtin_bit_cast(unsigned, v); }
__device__ __forceinline__ float ex2(float x) { return __builtin_amdgcn_exp2f(x); }
__device__ __forceinline__ float lg2(float x) { return __builtin_amdgcn_logf(x); }
__device__ __forceinline__ float rcpf_(float x) { return __builtin_amdgcn_rcpf(x); }
__device__ __forceinline__ float silu_f(float g) { return g * rcpf_(1.f + ex2(-1.4426950408889634f * g)); }
__device__ __forceinline__ float gelu_tanh_f(float x) { const float t = x * (1.f + 0.044715f * x * x); return x * rcpf_(1.f + ex2(-2.f * 0.7978845608028654f * 1.4426950408889634f * t)); }
typedef unsigned long long sq_t;
__device__ __forceinline__ sq_t sq_fix(float ss) { return (sq_t)(long long)(ss * 1048576.f); }
__device__ __forceinline__ void sq_add(sq_t* p, float ss) { atomicAdd(p, sq_fix(ss)); }
__device__ __forceinline__ float sq_read(const sq_t* p) { return (float)(long long)(*p) * (1.f / 1048576.f); }
__device__ __forceinline__ float wave_sum(float v) {
#pragma unroll
    for (int o = 1; o < 64; o <<= 1) v += __shfl_xor(v, o);
    return v;
}

struct EpiSwiGLU {
    static constexpr bool PERM = true, AFTER_DRAIN = false;
    bf16_t* H; const LAS float* rtab; bf16_t* Kb; bf16_t* VTb;
    __device__ __forceinline__ void operator()(const f32x4 (&acc)[2][2][4][2], const Unit& u, int wr, int wc, int fr_in, int fq_in) const {
        int fr = fr_in, fq = fq_in; asm volatile("" : "+v"(fr), "+v"(fq));
        const int row0 = u.pm * 256 + wr * 64 + fr;
        if (u.pn < 22) {
            const int col0 = u.pn * 128 + wc * 32 + 8 * fq;
#pragma unroll
            for (int ai = 0; ai < 2; ++ai)
#pragma unroll
                for (int m = 0; m < 4; ++m) {
                    const int row = row0 + ai * 128 + m * 16;
                    const float rr = rtab[u.ord * 256 + (row & 255)], cexp = -1.4426950408889634f * rr, rr2 = rr * rr;
                    float hv[8];
#pragma unroll
                    for (int n = 0; n < 2; ++n)
#pragma unroll
                        for (int j = 0; j < 4; ++j) { const float g = acc[ai][0][m][n][j]; hv[4 * n + j] = (g * acc[ai][1][m][n][j]) * rcpf_(1.f + ex2(g * cexp)) * rr2; }
                    u32x4 w; w.x = pk2(hv[0], hv[1]); w.y = pk2(hv[2], hv[3]); w.z = pk2(hv[4], hv[5]); w.w = pk2(hv[6], hv[7]);
                    *(u32x4*)(H + (size_t)row * FF + col0) = w;
                }
        } else {
            const int cb = (u.pn - 22) * 256 + wc * 32 + 8 * fq;
#pragma unroll
            for (int ai = 0; ai < 2; ++ai)
#pragma unroll
                for (int m = 0; m < 4; ++m) {
                    const int row = row0 + ai * 128 + m * 16, b = row >> 13, s = row & 8191;
                    const float rr = rtab[u.ord * 256 + (row & 255)];
#pragma unroll
                    for (int bj = 0; bj < 2; ++bj) {
                        const int c8 = cb + bj * 128;
                        float v[8];
#pragma unroll
                        for (int n = 0; n < 2; ++n)
#pragma unroll
                            for (int j = 0; j < 4; ++j) v[4 * n + j] = acc[ai][bj][m][n][j] * rr;
                        if (c8 < 768) {
                            const int hd = c8 >> 6, d = c8 & 63;
                            u32x4 w; w.x = pk2(v[0], v[1]); w.y = pk2(v[2], v[3]); w.z = pk2(v[4], v[5]); w.w = pk2(v[6], v[7]);
                            *(u32x4*)(Kb + ((size_t)(b * NH + hd) * SEQ + s) * 64 + d) = w;
                        } else {
                            const int cv = c8 - 768, hd = cv >> 6, d = cv & 63;
                            bf16_t* vp = VTb + (((size_t)(b * NH + hd) * (SEQ / 64) + (s >> 6)) * 64 + d) * 64 + (s & 63);
#pragma unroll
                            for (int e = 0; e < 8; e += 2) { const unsigned p = pk2(v[e], v[e + 1]); vp[e * 64] = (bf16_t)(p & 0xffffu); vp[(e + 1) * 64] = (bf16_t)(p >> 16); }
                        }
                    }
                }
        }
    }
};
struct EpiResid {
    static constexpr bool PERM = true, AFTER_DRAIN = false;
    bf16_t* XB; sq_t* rsq_out; float alpha;
    __device__ __forceinline__ void operator()(const f32x4 (&acc)[2][2][4][2], const Unit& u, int wr, int wc, int fr_in, int fq_in) const {
        int fr = fr_in, fq = fq_in; asm volatile("" : "+v"(fr), "+v"(fq));
        const int row0 = u.pm * 256 + wr * 64 + fr, col0 = u.pn * 256 + wc * 32 + 8 * fq;
#pragma unroll
        for (int ai = 0; ai < 2; ++ai) {
            u32x4 pre[4][2];
#pragma unroll
            for (int m = 0; m < 4; ++m)
#pragma unroll
                for (int bj = 0; bj < 2; ++bj) pre[m][bj] = *(const u32x4*)(XB + (size_t)(row0 + ai * 128 + m * 16) * DM + col0 + bj * 128);
#pragma unroll
            for (int m = 0; m < 4; ++m) {
                const int row = row0 + ai * 128 + m * 16; float ss = 0.f;
#pragma unroll
                for (int bj = 0; bj < 2; ++bj) {
                    float v[8];
#pragma unroll
                    for (int k = 0; k < 4; ++k) {
                        const unsigned w = pre[m][bj][k];
                        v[2 * k] = __uint_as_float(w << 16) + alpha * acc[ai][bj][m][k >> 1][2 * (k & 1)];
                        v[2 * k + 1] = __uint_as_float(w & 0xffff0000u) + alpha * acc[ai][bj][m][k >> 1][2 * (k & 1) + 1];
                        ss += v[2 * k] * v[2 * k] + v[2 * k + 1] * v[2 * k + 1];
                    }
                    u32x4 o; o.x = pk2(v[0], v[1]); o.y = pk2(v[2], v[3]); o.z = pk2(v[4], v[5]); o.w = pk2(v[6], v[7]);
                    *(u32x4*)(XB + (size_t)row * DM + col0 + bj * 128) = o;
                }
                ss += __shfl_xor(ss, 16); ss += __shfl_xor(ss, 32);
                if (fq == 0) sq_add(rsq_out + row, ss);
            }
            asm volatile("" ::: "memory");
        }
    }
};
struct EpiProjA {
    static constexpr bool PERM = true, AFTER_DRAIN = false;
    bf16_t* U; bf16_t* VTA; bf16_t* QM; const LAS float* rtab; sq_t* vsq;
    __device__ __forceinline__ void operator()(const f32x4 (&acc)[2][2][4][2], const Unit& u, int wr, int wc, int fr_in, int fq_in) const {
        int fr = fr_in, fq = fq_in; asm volatile("" : "+v"(fr), "+v"(fq));
        const int row0 = u.pm * 256 + wr * 64 + fr, cw = wc * 32 + 8 * fq;
#pragma unroll
        for (int ai = 0; ai < 2; ++ai)
#pragma unroll
            for (int m = 0; m < 4; ++m) {
                const int row = row0 + ai * 128 + m * 16, b = row >> 13, s = row & 8191;
                const float rr = rtab[u.ord * 256 + (row & 255)];
                float ss = 0.f;
#pragma unroll
                for (int bj = 0; bj < 2; ++bj) {
                    float v[8];
#pragma unroll
                    for (int n = 0; n < 2; ++n)
#pragma unroll
                        for (int j = 0; j < 4; ++j) v[4 * n + j] = acc[ai][bj][m][n][j] * rr;
                    if (u.pn < 6) {
#pragma unroll
                        for (int e = 0; e < 8; ++e) v[e] = gelu_tanh_f(v[e]);
                    }
                    if (u.pn < 3) {
                        u32x4 w; w.x = pk2(v[0], v[1]); w.y = pk2(v[2], v[3]); w.z = pk2(v[4], v[5]); w.w = pk2(v[6], v[7]);
                        *(u32x4*)(U + (size_t)row * 768 + u.pn * 256 + bj * 128 + cw) = w;
                    } else if (u.pn < 6) {
                        const int cv = (u.pn - 3) * 256 + bj * 128 + cw;
                        bf16_t* vp = VTA + (((size_t)b * (SEQ / 128) + (s >> 7)) * 768 + cv) * 128 + (s & 127);
#pragma unroll
                        for (int e = 0; e < 8; e += 2) { ss += v[e] * v[e] + v[e + 1] * v[e + 1]; const unsigned p = pk2(v[e], v[e + 1]); vp[e * 128] = (bf16_t)(p & 0xffffu); vp[(e + 1) * 128] = (bf16_t)(p >> 16); }
                    } else {
                        u32x4 w; w.x = pk2(v[0], v[1]); w.y = pk2(v[2], v[3]); w.z = pk2(v[4], v[5]); w.w = pk2(v[6], v[7]);
                        *(u32x4*)(QM + (size_t)row * 256 + bj * 128 + cw) = w;
                    }
                }
                if (u.pn >= 3 && u.pn < 6) { ss += __shfl_xor(ss, 16); ss += __shfl_xor(ss, 32); if (fq == 0) sq_add(vsq + row, ss); }
            }
    }
};
struct EpiProjB {
    static constexpr bool PERM = true, AFTER_DRAIN = false;
    bf16_t* P; const LAS float* rtab;
    __device__ __forceinline__ void operator()(const f32x4 (&acc)[2][2][4][2], const Unit& u, int wr, int wc, int fr_in, int fq_in) const {
        int fr = fr_in, fq = fq_in; asm volatile("" : "+v"(fr), "+v"(fq));
        const int row0 = u.pm * 256 + wr * 64 + fr, col0 = u.pn * 256 + wc * 32 + 8 * fq;
#pragma unroll
        for (int ai = 0; ai < 2; ++ai)
#pragma unroll
            for (int m = 0; m < 4; ++m) {
                const int row = row0 + ai * 128 + m * 16;
                const float rr = rtab[u.ord * 256 + (row & 255)];
#pragma unroll
                for (int bj = 0; bj < 2; ++bj) {
                    const f32x4 v0 = acc[ai][bj][m][0] * rr, v1 = acc[ai][bj][m][1] * rr;
                    u32x4 w; w.x = pk2(v0[0], v0[1]); w.y = pk2(v0[2], v0[3]); w.z = pk2(v1[0], v1[1]); w.w = pk2(v1[2], v1[3]);
                    *(u32x4*)(P + (size_t)row * DM + col0 + bj * 128) = w;
                }
            }
    }
};
struct EpiMemKV {
    static constexpr bool PERM = true, AFTER_DRAIN = false;
    bf16_t* KM; bf16_t* VMT; const sq_t* memsq;
    __device__ __forceinline__ void operator()(const f32x4 (&acc)[2][2][4][2], const Unit& u, int wr, int wc, int fr_in, int fq_in) const {
        int fr = fr_in, fq = fq_in; asm volatile("" : "+v"(fr), "+v"(fq));
        const int row0 = u.pm * 256 + wr * 64 + fr;
#pragma unroll
        for (int ai = 0; ai < 2; ++ai)
#pragma unroll
            for (int m = 0; m < 4; ++m) {
                const int row = row0 + ai * 128 + m * 16, b = row >> 8, key = row & 255;
                const float rr = __builtin_amdgcn_rsqf(sq_read(memsq + row) * (1.f / 1024.f) + EPS);
#pragma unroll
                for (int bj = 0; bj < 2; ++bj) {
                    const int c = u.pn * 256 + bj * 128 + wc * 32 + 8 * fq, l = c >> 9, cc = c & 511;
                    float v[8];
#pragma unroll
                    for (int n = 0; n < 2; ++n)
#pragma unroll
                        for (int j = 0; j < 4; ++j) v[4 * n + j] = acc[ai][bj][m][n][j] * rr;
                    if (cc < 256) {
                        const int head = cc >> 6, d = cc & 63;
                        u32x4 w; w.x = pk2(v[0], v[1]); w.y = pk2(v[2], v[3]); w.z = pk2(v[4], v[5]); w.w = pk2(v[6], v[7]);
                        *(u32x4*)(KM + ((size_t)((l * 2 + b) * 4 + head) * 256 + key) * 64 + d) = w;
                    } else {
                        const int cv = cc - 256, head = cv >> 6, d = cv & 63;
                        bf16_t* vp = VMT + (((size_t)((l * 2 + b) * 4 + head) * 4 + (key >> 6)) * 64 + d) * 64 + (key & 63);
#pragma unroll
                        for (int e = 0; e < 8; e += 2) { const unsigned p = pk2(v[e], v[e + 1]); vp[e * 64] = (bf16_t)(p & 0xffffu); vp[(e + 1) * 64] = (bf16_t)(p >> 16); }
                    }
                }
            }
    }
};


__device__ __forceinline__ void tile_load(const bf16_t* __restrict__ g, size_t gstride, u32x4 (&r)[8], int lane) {
    const bf16_t* p = g + (size_t)(lane >> 3) * gstride + 8 * (lane & 7);
#pragma unroll
    for (int i = 0; i < 8; ++i) r[i] = *(const u32x4*)(p + (size_t)(8 * i) * gstride);
}
__device__ __forceinline__ void tile_store(LAS unsigned char* t, const u32x4 (&r)[8], int lane) {
#pragma unroll
    for (int i = 0; i < 8; ++i) { const int row = 8 * i + (lane >> 3); *(LAS u32x4*)(t + row * 128 + ((((lane & 7) ^ (row >> 1)) & 7) << 4)) = r[i]; }
}
__device__ __forceinline__ bf16x8 tile_frag(const LAS unsigned char* t, int row, int chunk) { return *(const LAS bf16x8*)(t + row * 128 + (((chunk ^ (row >> 1)) & 7) << 4)); }

__device__ __forceinline__ void qtile_to_frags(const bf16_t* __restrict__ g  , size_t pitch, LAS unsigned char* img  , bf16x8 (&qf)[4], int lane) {
    u32x4 r[4];
    const bf16_t* p = g + (size_t)(lane >> 3) * pitch + 8 * (lane & 7);
#pragma unroll
    for (int i = 0; i < 4; ++i) r[i] = *(const u32x4*)(p + (size_t)(8 * i) * pitch);
#pragma unroll
    for (int i = 0; i < 4; ++i) { const int row = 8 * i + (lane >> 3); *(LAS u32x4*)(img + row * 128 + ((((lane & 7) ^ (row >> 1)) & 7) << 4)) = r[i]; }
#pragma unroll
    for (int ks = 0; ks < 4; ++ks) qf[ks] = tile_frag(img, lane & 31, 2 * ks + (lane >> 5));
}
__device__ __forceinline__ void otile_store(const f32x16& o0, const f32x16& o1, float scale, LAS unsigned char* img  , bf16_t* __restrict__ g  , int lane) {
    const int q = lane & 31, h = lane >> 5;
#pragma unroll
    for (int g4 = 0; g4 < 4; ++g4) {
        u32x2 w0, w1;
        w0.x = pk2(o0[4 * g4] * scale, o0[4 * g4 + 1] * scale); w0.y = pk2(o0[4 * g4 + 2] * scale, o0[4 * g4 + 3] * scale);
        w1.x = pk2(o1[4 * g4] * scale, o1[4 * g4 + 1] * scale); w1.y = pk2(o1[4 * g4 + 2] * scale, o1[4 * g4 + 3] * scale);
        *(LAS u32x2*)(img + q * 128 + (((g4 ^ (q >> 1)) & 7) << 4) + 8 * h) = w0;
        *(LAS u32x2*)(img + q * 128 + ((((4 + g4) ^ (q >> 1)) & 7) << 4) + 8 * h) = w1;
    }
#pragma unroll
    for (int i = 0; i < 4; ++i) { const int row = 8 * i + (lane >> 3), c = lane & 7; const u32x4 v = *(const LAS u32x4*)(img + row * 128 + (((c ^ (row >> 1)) & 7) << 4)); *(u32x4*)(g + (size_t)row * DM + 8 * c) = v; }
}

__device__ __forceinline__ void sb_attn_wave(const bf16_t* __restrict__ P, const bf16_t* __restrict__ Kb, const bf16_t* __restrict__ VTb, bf16_t* __restrict__ Y, int b, int hd, int qb, int lane, LAS unsigned char* tl  ) {
    const int q = lane & 31, h = lane >> 5;
    const int kap = 16 * ((q >> 2) & 1) + (q & 3) + 4 * (q >> 3);
    const int qpos = qb * 32 + q;
    bf16x8 qf[4];
    const bf16_t* Kh = Kb + (size_t)(b * NH + hd) * SEQ * 64;
    const bf16_t* Vh = VTb + (size_t)(b * NH + hd) * 64 * SEQ;
    LAS unsigned char* Kt = tl; LAS unsigned char* Vt = tl + 8192;
    u32x4 rk[8], rv[8];
    { const int kf = ((qb * 32 + 31) >> 6) * 64; tile_load(Kh + (size_t)kf * 64, 64, rk, lane); tile_load(Vh + (size_t)kf * 64, 64, rv, lane); }
    qtile_to_frags(P + (size_t)(b * SEQ + qb * 32) * DM + hd * 64, DM, Vt, qf, lane);
    f32x16 o0, o1;
#pragma unroll
    for (int i = 0; i < 16; ++i) { o0[i] = 0.f; o1[i] = 0.f; }
    float carry = 1.f;
    const float c1 = 0.125f * 1.4426950408889634f;
    for (int kt = (qb * 32 + 31) >> 6; kt >= 0; --kt) {
        const int k0 = kt * 64;
        tile_store(Kt, rk, lane); tile_store(Vt, rv, lane);
        if (kt > 0) { tile_load(Kh + (size_t)(k0 - 64) * 64, 64, rk, lane); tile_load(Vh + (size_t)(k0 - 64) * 64, 64, rv, lane); }
        f32x16 s0, s1;
#pragma unroll
        for (int i = 0; i < 16; ++i) { s0[i] = 0.f; s1[i] = 0.f; }
#pragma unroll
        for (int ks = 0; ks < 4; ++ks) {
            const bf16x8 a0 = tile_frag(Kt, kap, 2 * ks + h), a1 = tile_frag(Kt, 32 + kap, 2 * ks + h);
            s0 = MFMA32(a0, qf[ks], s0); s1 = MFMA32(a1, qf[ks], s1);
        }
        const int kb0 = k0 + 16 * h, kb1 = kb0 + 32;
        float T0 = 1.f, T1 = 1.f;
        if (k0 + 64 <= qb * 32) {
#pragma unroll
            for (int r = 0; r < 16; ++r) {
                { const float t = ex2(-fmaxf(s0[r] * c1, -60.f)); const float be = rcpf_(1.f + t); s0[r] = be; T0 *= t * be; }
                { const float t = ex2(-fmaxf(s1[r] * c1, -60.f)); const float be = rcpf_(1.f + t); s1[r] = be; T1 *= t * be; }
            }
        } else {
#pragma unroll
            for (int r = 0; r < 16; ++r) {
                { const float z = s0[r] * c1; const float t = ex2(-fabsf(z)); const float rc = rcpf_(1.f + t), tr = t * rc; const bool cz = (kb0 + r < qpos); s0[r] = cz ? (z >= 0.f ? rc : tr) : 0.f; T0 *= cz ? (z >= 0.f ? tr : rc) : 1.f; }
                { const float z = s1[r] * c1; const float t = ex2(-fabsf(z)); const float rc = rcpf_(1.f + t), tr = t * rc; const bool cz = (kb1 + r < qpos); s1[r] = cz ? (z >= 0.f ? rc : tr) : 0.f; T1 *= cz ? (z >= 0.f ? tr : rc) : 1.f; }
            }
        }
        const float To0 = __shfl_xor(T0, 32), To1 = __shfl_xor(T1, 32);
        const float off1 = h ? 1.f : To1;
        const float off0 = h ? (To1 * T1) : (To0 * (T1 * To1));
        float run = carry * off1;
#pragma unroll
        for (int r = 15; r >= 0; --r) { const float be = s1[r]; s1[r] = be * run; run *= (1.f - be); }
        run = carry * off0;
#pragma unroll
        for (int r = 15; r >= 0; --r) { const float be = s0[r]; s0[r] = be * run; run *= (1.f - be); }
        carry *= (T0 * T1) * (To0 * To1);
#pragma unroll
        for (int s2 = 0; s2 < 2; ++s2) {
            u32x4 p0, p1;
            p0.x = pk2(s0[8 * s2 + 0], s0[8 * s2 + 1]); p0.y = pk2(s0[8 * s2 + 2], s0[8 * s2 + 3]); p0.z = pk2(s0[8 * s2 + 4], s0[8 * s2 + 5]); p0.w = pk2(s0[8 * s2 + 6], s0[8 * s2 + 7]);
            p1.x = pk2(s1[8 * s2 + 0], s1[8 * s2 + 1]); p1.y = pk2(s1[8 * s2 + 2], s1[8 * s2 + 3]); p1.z = pk2(s1[8 * s2 + 4], s1[8 * s2 + 5]); p1.w = pk2(s1[8 * s2 + 6], s1[8 * s2 + 7]);
            const bf16x8 pf0 = __builtin_bit_cast(bf16x8, p0), pf1 = __builtin_bit_cast(bf16x8, p1);
            const bf16x8 va00 = tile_frag(Vt, q, 2 * h + s2), va01 = tile_frag(Vt, 32 + q, 2 * h + s2);
            const bf16x8 va10 = tile_frag(Vt, q, 4 + 2 * h + s2), va11 = tile_frag(Vt, 32 + q, 4 + 2 * h + s2);
            o0 = MFMA32(va00, pf0, o0); o1 = MFMA32(va01, pf0, o1);
            o0 = MFMA32(va10, pf1, o0); o1 = MFMA32(va11, pf1, o1);
        }
        if (__all(carry < 1e-37f)) break;
    }
    otile_store(o0, o1, 1.f, Kt, Y + (size_t)(b * SEQ + qb * 32) * DM + hd * 64, lane);
}

__device__ __forceinline__ void mem_attn_wave(const bf16_t* __restrict__ Qrow  , int qpitch, const bf16_t* __restrict__ Km  , const bf16_t* __restrict__ Vm  ,
                                              bf16_t* __restrict__ Yrow  , int lane, LAS unsigned char* tl  ) {
    const int q = lane & 31, h = lane >> 5;
    const int kap = 16 * ((q >> 2) & 1) + (q & 3) + 4 * (q >> 3);
    bf16x8 qf[4];
    LAS unsigned char* Kt = tl; LAS unsigned char* Vt = tl + 8192;
    u32x4 rk[8], rv[8];
    tile_load(Km, 64, rk, lane); tile_load(Vm, 64, rv, lane);
    qtile_to_frags(Qrow, (size_t)qpitch, Vt, qf, lane);
    f32x16 o0, o1;
#pragma unroll
    for (int i = 0; i < 16; ++i) { o0[i] = 0.f; o1[i] = 0.f; }
    const float c1 = 0.125f * 1.4426950408889634f;
    float mrun = -3.0e38f, sum = 0.f;
#pragma unroll 1
    for (int t = 0; t < 4; ++t) {
        tile_store(Kt, rk, lane); tile_store(Vt, rv, lane);
        if (t < 3) { tile_load(Km + (size_t)(t + 1) * 64 * 64, 64, rk, lane); tile_load(Vm + (size_t)(t + 1) * 64 * 64, 64, rv, lane); }
        f32x16 s0, s1;
#pragma unroll
        for (int i = 0; i < 16; ++i) { s0[i] = 0.f; s1[i] = 0.f; }
#pragma unroll
        for (int ks = 0; ks < 4; ++ks) { s0 = MFMA32(tile_frag(Kt, kap, 2 * ks + h), qf[ks], s0); s1 = MFMA32(tile_frag(Kt, 32 + kap, 2 * ks + h), qf[ks], s1); }
        float mt = -3.0e38f;
#pragma unroll
        for (int i = 0; i < 16; ++i) mt = fmaxf(mt, fmaxf(s0[i], s1[i]));
        mt = fmaxf(mt, __shfl_xor(mt, 32));
        const float mnew = fmaxf(mrun, mt), alpha = ex2((mrun - mnew) * c1), mb = mnew * c1;
        mrun = mnew; sum *= alpha;
#pragma unroll
        for (int i = 0; i < 16; ++i) { const float p0 = ex2(s0[i] * c1 - mb), p1 = ex2(s1[i] * c1 - mb); s0[i] = p0; s1[i] = p1; sum += p0 + p1; o0[i] *= alpha; o1[i] *= alpha; }
#pragma unroll
        for (int s2 = 0; s2 < 2; ++s2) {
            u32x4 p0, p1;
            p0.x = pk2(s0[8 * s2 + 0], s0[8 * s2 + 1]); p0.y = pk2(s0[8 * s2 + 2], s0[8 * s2 + 3]); p0.z = pk2(s0[8 * s2 + 4], s0[8 * s2 + 5]); p0.w = pk2(s0[8 * s2 + 6], s0[8 * s2 + 7]);
            p1.x = pk2(s1[8 * s2 + 0], s1[8 * s2 + 1]); p1.y = pk2(s1[8 * s2 + 2], s1[8 * s2 + 3]); p1.z = pk2(s1[8 * s2 + 4], s1[8 * s2 + 5]); p1.w = pk2(s1[8 * s2 + 6], s1[8 * s2 + 7]);
            const bf16x8 pf0 = __builtin_bit_cast(bf16x8, p0), pf1 = __builtin_bit_cast(bf16x8, p1);
            o0 = MFMA32(tile_frag(Vt, q, 2 * h + s2), pf0, o0); o1 = MFMA32(tile_frag(Vt, 32 + q, 2 * h + s2), pf0, o1);
            o0 = MFMA32(tile_frag(Vt, q, 4 + 2 * h + s2), pf1, o0); o1 = MFMA32(tile_frag(Vt, 32 + q, 4 + 2 * h + s2), pf1, o1);
        }
    }
    sum += __shfl_xor(sum, 32);
    otile_store(o0, o1, 1.f / sum, Kt, Yrow, lane);
}

__device__ __forceinline__ void gmlp_wave(const float* __restrict__ Wg  , const float* __restrict__ bias  , const float* __restrict__ gain  ,
                                          const bf16_t* __restrict__ VT  , const sq_t* __restrict__ vsq  , const bf16_t* __restrict__ Ur  ,
                                          bf16_t* __restrict__ Yr  , int tblk, int lane, LAS float* rvs  , LAS unsigned char* tl  ) {
    const int q = lane & 31, h = lane >> 5;
    f32x16 X[4];
#pragma unroll
    for (int cb = 0; cb < 4; ++cb)
#pragma unroll
        for (int i = 0; i < 16; ++i) X[cb][i] = 0.f;
    const int nsh = tblk < 2 ? 1 : 2;
    u32x4 rk[8];
    tile_load(VT, 128, rk, lane);
    {
        f32x2v r; r.x = __builtin_amdgcn_rsqf(sq_read(vsq + 2 * lane) * (1.f / 768.f) + EPS); r.y = __builtin_amdgcn_rsqf(sq_read(vsq + 2 * lane + 1) * (1.f / 768.f) + EPS);
        *(LAS f32x2v*)(rvs + 2 * lane) = r; asm volatile("s_waitcnt lgkmcnt(0)" ::: "memory");
    }
    const float* wld = Wg + (32 * tblk + (lane >> 4)) * 128 + 4 * (lane & 15);
    f32x4 rw[8];
#pragma unroll
    for (int i = 0; i < 8; ++i) rw[i] = *(const f32x4*)(wld + (4 * i) * 128);
#pragma unroll 1
    for (int sh = 0; sh < nsh; ++sh) {
        bf16x8 af[4];
        {
            LAS unsigned char* wimg = tl + 8192;
#pragma unroll
            for (int i = 0; i < 8; ++i) { const int tl_ = 4 * i + (lane >> 4), rho = 2 * tl_ + ((lane >> 3) & 1); *(LAS f32x4*)(wimg + rho * 128 + ((((lane & 7) ^ tl_) & 7) << 4)) = rw[i]; }
            if (sh + 1 < nsh) {
#pragma unroll
                for (int i = 0; i < 8; ++i) rw[i] = *(const f32x4*)(wld + (4 * i) * 128 + 64 * (sh + 1));
            }
        }
#pragma unroll
        for (int k4 = 0; k4 < 4; ++k4) {
            const int ks = 4 * sh + k4;
            const LAS unsigned char* wr_ = tl + 8192 + (2 * q + (k4 >> 1)) * 128; const int c16 = 4 * (k4 & 1) + 2 * h;
            const f32x4 w0 = *(const LAS f32x4*)(wr_ + (((c16 ^ q) & 7) << 4)), w1 = *(const LAS f32x4*)(wr_ + ((((c16 + 1) ^ q) & 7) << 4));
            const f32x4 q0 = *(const LAS f32x4*)(rvs + 16 * ks + 8 * h), q1 = *(const LAS f32x4*)(rvs + 16 * ks + 8 * h + 4);
            u32x4 ap; ap.x = pk2(w0[0] * q0[0], w0[1] * q0[1]); ap.y = pk2(w0[2] * q0[2], w0[3] * q0[3]); ap.z = pk2(w1[0] * q1[0], w1[1] * q1[1]); ap.w = pk2(w1[2] * q1[2], w1[3] * q1[3]);
            af[k4] = __builtin_bit_cast(bf16x8, ap);
        }
#pragma unroll
        for (int ch = 0; ch < 2; ++ch) {
            LAS unsigned char* img = tl + ch * 8192;
            tile_store(img, rk, lane);
            if (ch == 0) tile_load(VT + 64 * 128 + 64 * sh, 128, rk, lane);
            else if (sh + 1 < nsh) tile_load(VT + 64 * (sh + 1), 128, rk, lane);
#pragma unroll
            for (int k4 = 0; k4 < 4; ++k4)
#pragma unroll
                for (int c2 = 0; c2 < 2; ++c2) X[2 * ch + c2] = MFMA32(af[k4], tile_frag(img, 32 * c2 + q, 2 * k4 + h), X[2 * ch + c2]);
        }
    }
    LAS float* mt = (LAS float*)tl;
    f32x4 bv[4];
#pragma unroll
    for (int g4 = 0; g4 < 4; ++g4) bv[g4] = *(const f32x4*)(bias + 32 * tblk + 8 * g4 + 4 * h);
#pragma unroll
    for (int cb = 0; cb < 4; ++cb) {
        const float gn = gain[32 * cb + q];
#pragma unroll
        for (int i = 0; i < 16; ++i) mt[((i & 3) + 8 * (i >> 2) + 4 * h) * 128 + 32 * cb + q] = gn * X[cb][i] + bv[i >> 2][i & 3];
    }
#pragma unroll
    for (int i8 = 0; i8 < 8; ++i8) {
        const int t = 4 * i8 + (lane >> 4), c8 = 8 * (lane & 15);
        const u32x4 uu = *(const u32x4*)(Ur + (size_t)(32 * tblk + t) * 768 + c8);
        const f32x4 m0 = *(const LAS f32x4*)(mt + t * 128 + c8), m1 = *(const LAS f32x4*)(mt + t * 128 + c8 + 4);
        u32x4 o;
        o.x = pk2(__uint_as_float(uu.x << 16) * m0[0], __uint_as_float(uu.x & 0xffff0000u) * m0[1]); o.y = pk2(__uint_as_float(uu.y << 16) * m0[2], __uint_as_float(uu.y & 0xffff0000u) * m0[3]);
        o.z = pk2(__uint_as_float(uu.z << 16) * m1[0], __uint_as_float(uu.z & 0xffff0000u) * m1[1]); o.w = pk2(__uint_as_float(uu.w << 16) * m1[2], __uint_as_float(uu.w & 0xffff0000u) * m1[3]);
        *(u32x4*)(Yr + (size_t)(32 * tblk + t) * DM + c8) = o;
    }
}

#define LDS_WAIT() asm volatile("s_waitcnt lgkmcnt(0)" ::: "memory")
struct WItem { const float* src; const float* g; bf16_t* dst; int N, K, k0, n0, drow0; bool valid; };
__device__ __forceinline__ WItem witem_decode(const cparams_t p, int it) {
    constexpr int IT_G = 16 * 88, IT_MEM = 16 * 16, IT_IN = 16 * 56, IT_OUT = 16 * 32, IT_LAYER = 6 * IT_G + IT_MEM + IT_IN + IT_OUT;
    bf16_t* Wb = (bf16_t*)(p->ws + WS_W);
    WItem w; w.g = nullptr; w.K = 1024; w.valid = true;
    if (it >= 4 * IT_LAYER) {
        const int r = it - 4 * IT_LAYER; w.N = 1536; w.k0 = 64 * (r / 48); w.n0 = 32 * (r % 48); w.drow0 = 5632 + w.n0; w.src = p->w_kv; w.g = p->kv_norm; w.dst = Wb + 2 * L_STRIDE + L_GU1;
    } else {
        const int l = it / IT_LAYER; int r = it % IT_LAYER; bf16_t* Wl = Wb + (size_t)l * L_STRIDE;
        if (r < 6 * IT_G) {
            const int j = r / IT_G, rr = r % IT_G, half = j / 3, kind = j % 3;
            if (kind < 2) {
                w.N = FF; w.k0 = 64 * (rr / 88); w.n0 = 32 * (rr % 88); w.drow0 = 256 * (w.n0 >> 7) + (w.n0 & 127) + 128 * kind;
                w.src = (half ? (kind ? p->ffn2_wu : p->ffn2_wg) : (kind ? p->ffn1_wu : p->ffn1_wg)) + (size_t)l * 1024 * FF;
                w.g = (half ? p->ffn2_norm : p->ffn1_norm) + l * 1024; w.dst = Wl + (half ? L_GU2 : L_GU1);
            } else {
                w.K = FF; w.N = 1024; w.k0 = 64 * (rr / 32); w.n0 = 32 * (rr % 32); w.drow0 = w.n0;
                w.src = (half ? p->ffn2_wd : p->ffn1_wd) + (size_t)l * FF * 1024; w.dst = Wl + (half ? L_D2 : L_D1);
            }
        } else {
            r -= 6 * IT_G;
            if (r < IT_MEM) { w.N = 512; w.k0 = 64 * (r / 16); w.n0 = 32 * (r % 16); w.drow0 = l * 512 + w.n0; w.src = p->w_mem_kv + (size_t)l * 1024 * 512; w.g = p->mem_norm; w.dst = (bf16_t*)(p->ws + WS_WMEM); }
            else {
                r -= IT_MEM;
                if (r < IT_IN) {
                    if (l < 2) { w.N = 1792; w.k0 = 64 * (r / 56); w.n0 = 32 * (r % 56); w.src = p->a_w_in + (size_t)l * 1024 * 1792; }
                    else { w.valid = r < 512; r &= 511; w.N = 1024; w.k0 = 64 * (r / 32); w.n0 = 32 * (r % 32); w.src = p->b_w_in + (size_t)(l - 2) * 1024 * 1024; }
                    w.drow0 = w.n0; w.g = p->mix_norm + l * 1024; w.dst = Wl + L_IN;
                } else {
                    r -= IT_IN; w.N = 1024; w.k0 = 64 * (r / 32); w.n0 = 32 * (r % 32); w.drow0 = w.n0;
                    w.src = (l < 2 ? p->a_w_out + (size_t)l * 1024 * 1024 : p->b_w_out + (size_t)(l - 2) * 1024 * 1024); w.dst = Wl + L_OUT;
                }
            }
        }
    }
    return w;
}
__device__ __forceinline__ void witem_load(const WItem& w, f32x4 (&v)[8], float (&gs)[8], int lane) {
    const float* sp = w.src + (size_t)(w.k0 + (lane >> 3)) * w.N + w.n0 + 4 * (lane & 7);
#pragma unroll
    for (int i = 0; i < 8; ++i) { v[i] = *(const f32x4*)(sp + (size_t)(8 * i) * w.N); gs[i] = w.g ? w.g[w.k0 + 8 * i + (lane >> 3)] : 1.f; }
}
__device__ __forceinline__ void witem_store(const WItem& w, const f32x4 (&v)[8], const float (&gs)[8], LAS float* scr, int lane) {
#pragma unroll
    for (int i = 0; i < 8; ++i) { LAS float* d = scr + (8 * i + (lane >> 3)) * 33 + 4 * (lane & 7); d[0] = v[i][0] * gs[i]; d[1] = v[i][1] * gs[i]; d[2] = v[i][2] * gs[i]; d[3] = v[i][3] * gs[i]; }
    LDS_WAIT();
    const int c = lane & 7;
#pragma unroll
    for (int j = 0; j < 4; ++j) { const int n = (lane >> 3) + 8 * j; const LAS float* s = scr + (8 * c) * 33 + n;
        u32x4 o; o.x = pk2(s[0 * 33], s[1 * 33]); o.y = pk2(s[2 * 33], s[3 * 33]); o.z = pk2(s[4 * 33], s[5 * 33]); o.w = pk2(s[6 * 33], s[7 * 33]);
        *(u32x4*)(w.dst + (size_t)(w.drow0 + n) * w.K + w.k0 + 8 * c) = o; }
    LDS_WAIT();
}

constexpr int WI_G = 16 * 88, WI_MEM = 16 * 16, WI_LAYER = 6 * WI_G + WI_MEM + 16 * 56 + 16 * 32, WI_KV = 16 * 48;
constexpr int WI_UPFRONT = WI_LAYER + 3 * WI_MEM, WI_DEFERRED = 3 * WI_LAYER + WI_KV, WI_SLICE = (WI_DEFERRED + 4) / 5;
__device__ __forceinline__ int wi_map(bool deferred, int i, bool& skip) {
    skip = false;
    if (!deferred) { if (i < WI_LAYER) return i; const int m = i - WI_LAYER; return (1 + m / WI_MEM) * WI_LAYER + 6 * WI_G + (m % WI_MEM); }
    int it;
    if (i < 2 * WI_LAYER) it = WI_LAYER + i; else if (i < 2 * WI_LAYER + WI_KV) return 4 * WI_LAYER + (i - 2 * WI_LAYER); else it = 3 * WI_LAYER + (i - 2 * WI_LAYER - WI_KV);
    const int r = it % WI_LAYER; skip = (r >= 6 * WI_G && r < 6 * WI_G + WI_MEM);
    return it;
}
__device__ __forceinline__ void convert_items(const cparams_t p, LAS float* scr, bool deferred, int lo, int hi, int w, int NW, int lane) {
    int i = lo + w; if (i >= hi) return;
    bool sk; WItem cur = witem_decode(p, wi_map(deferred, i, sk)); cur.valid = cur.valid && !sk; f32x4 v[8]; float gs[8];
    if (cur.valid) witem_load(cur, v, gs, lane);
    for (;;) {
        const int in_ = i + NW; const bool has = in_ < hi;
        WItem nx = cur; f32x4 v2[8]; float gs2[8];
        if (has) { bool sk2; nx = witem_decode(p, wi_map(deferred, in_, sk2)); nx.valid = nx.valid && !sk2; if (nx.valid) witem_load(nx, v2, gs2, lane); }
        if (cur.valid) witem_store(cur, v, gs, scr, lane);
        if (!has) break;
        cur = nx; i = in_;
#pragma unroll
        for (int k = 0; k < 8; ++k) { v[k] = v2[k]; gs[k] = gs2[k]; }
    }
}
__device__ __forceinline__ void prologue(const cparams_t p, LAS unsigned char* lds, int gw, int NGW, int wave, int lane) {
    LAS float* scr = (LAS float*)(lds + wave * 16384);
    convert_items(p, scr, false, 0, WI_UPFRONT, gw, NGW, lane);
    sq_t* rs0 = (sq_t*)(p->ws + WS_CTL + CTL_ROWSQ);
    bf16_t* XB = (bf16_t*)(p->ws + WS_XB);
    for (int m = gw; m < MROWS; m += 2 * NGW) {
        const bool two = (m + NGW) < MROWS; const int m2 = two ? m + NGW : m;
        const f32x4* xr = (const f32x4*)(p->x + (size_t)m * DM) + lane; u32x2* brow = (u32x2*)(XB + (size_t)m * DM) + lane;
        const f32x4* xr2 = (const f32x4*)(p->x + (size_t)m2 * DM) + lane; u32x2* brow2 = (u32x2*)(XB + (size_t)m2 * DM) + lane;
        f32x4 va[4], vb[4];
#pragma unroll
        for (int j = 0; j < 4; ++j) { va[j] = xr[64 * j]; vb[j] = xr2[64 * j]; }
        float ss = 0.f, ss2 = 0.f;
#pragma unroll
        for (int j = 0; j < 4; ++j) {
            u32x2 w; w.x = pk2(va[j][0], va[j][1]); w.y = pk2(va[j][2], va[j][3]); brow[64 * j] = w; ss += (va[j][0] * va[j][0] + va[j][1] * va[j][1]) + (va[j][2] * va[j][2] + va[j][3] * va[j][3]);
            u32x2 w2; w2.x = pk2(vb[j][0], vb[j][1]); w2.y = pk2(vb[j][2], vb[j][3]); if (two) brow2[64 * j] = w2; ss2 += (vb[j][0] * vb[j][0] + vb[j][1] * vb[j][1]) + (vb[j][2] * vb[j][2] + vb[j][3] * vb[j][3]);
        }
        ss = wave_sum(ss); ss2 = wave_sum(ss2);
        if (lane == 0) { rs0[m] = sq_fix(ss); if (two) rs0[m2] = sq_fix(ss2); }
    }
    sq_t* msq = (sq_t*)(p->ws + WS_CTL + CTL_MEMSQ);
    bf16_t* MB = (bf16_t*)(p->ws + WS_MEMB);
    for (int m = gw; m < BATCH * NMEM; m += NGW) {
        const f32x4* xr = (const f32x4*)(p->mem + (size_t)m * DM) + lane; u32x2* brow = (u32x2*)(MB + (size_t)m * DM) + lane;
        float ss = 0.f;
#pragma unroll
        for (int j = 0; j < 4; ++j) { const f32x4 v = xr[64 * j]; u32x2 w; w.x = pk2(v[0], v[1]); w.y = pk2(v[2], v[3]); brow[64 * j] = w; ss += (v[0] * v[0] + v[1] * v[1]) + (v[2] * v[2] + v[3] * v[3]); }
        ss = wave_sum(ss);
        if (lane == 0) msq[m] = sq_fix(ss);
    }
}

#define XB_TMO      128
#define XB_XCNT(j)  (256  + 64 * (j))
#define XB_XSUB(j)  (1280 + 64 * (j))
#define XB_XGEN(j)  (2304 + 64 * (j))
#define XB_TOP      3328
#define XB_TOPGEN   3392
#define XCD_BAR_WORDS 3456
#define XB_SPIN_CAP (1u << 18)

__device__ __forceinline__ unsigned xb_ld(unsigned* p)              { return __hip_atomic_load(p, __ATOMIC_RELAXED, __HIP_MEMORY_SCOPE_AGENT); }
__device__ __forceinline__ unsigned xb_add(unsigned* p, unsigned v) { return __hip_atomic_fetch_add(p, v, __ATOMIC_RELAXED, __HIP_MEMORY_SCOPE_AGENT); }
__device__ __forceinline__ unsigned xb_xcc_id() { return (unsigned)__builtin_amdgcn_s_getreg((3 << 11) | 20) & 0xFu; }
#define XB_SPIN(cond, bar) do { unsigned _sp = 0; while (cond) { __builtin_amdgcn_s_sleep(1); \
    if ((++_sp & 255u) == 0u) { if (xb_ld(&(bar)[XB_TMO])) break; if (_sp > XB_SPIN_CAP) { atomicAdd(&(bar)[XB_TMO], 1u); break; } } } } while (0)

struct XcdBarrier {
    unsigned* bar; unsigned x;
    volatile LAS unsigned* st;
};

__device__ __forceinline__ XcdBarrier xcd_barrier_post(unsigned* bar, volatile LAS unsigned* st) {
    XcdBarrier b; b.bar = bar; b.x = xb_xcc_id(); b.st = st;
    if (threadIdx.x == 0) (void)xb_add(&bar[XB_XCNT(b.x)], 1u);
    return b;
}
__device__ __forceinline__ void xcd_barrier_complete(unsigned* bar, unsigned x, unsigned& nloc, unsigned& nx) {
    const unsigned G = gridDim.x * gridDim.y * gridDim.z;
    unsigned sum, cnt, mine, sp = 0u;
    for (;;) {
        sum = 0u; cnt = 0u; mine = 0u;
#pragma unroll
        for (unsigned j = 0; j < 16; ++j) { const unsigned c = xb_ld(&bar[XB_XCNT(j)]); sum += c; cnt += (c > 0u) ? 1u : 0u; mine = (j == x) ? c : mine; }
        if (sum == G) break;
        __builtin_amdgcn_s_sleep(1);
        if ((++sp & 255u) == 0u) { if (xb_ld(&bar[XB_TMO])) break; if (sp > XB_SPIN_CAP) { atomicAdd(&bar[XB_TMO], 1u); break; } }
    }
    nloc = mine > 0u ? mine : 1u; nx = cnt > 0u ? cnt : 1u;
}

__device__ __forceinline__ void xcd_barrier(const XcdBarrier& b) {
    asm volatile("s_waitcnt vmcnt(0)" ::: "memory");
    __syncthreads();
    if (threadIdx.x == 0) {
        unsigned* bar = b.bar;
        __builtin_amdgcn_s_waitcnt(0);
        unsigned nloc = b.st[0], nx = b.st[1];
        if (nloc == 0u) { xcd_barrier_complete(bar, b.x, nloc, nx); b.st[0] = nloc; b.st[1] = nx; }
        const unsigned old = xb_add(&bar[XB_XSUB(b.x)], 1u);
        const unsigned gen = old / nloc;
        if (old + 1u == (gen + 1u) * nloc) {
            __builtin_amdgcn_fence(__ATOMIC_RELEASE, "agent");
            asm volatile("s_waitcnt vmcnt(0)" ::: "memory");
            const unsigned og = xb_add(&bar[XB_TOP], 1u);
            const unsigned tg = og / nx;
            if (og + 1u == (tg + 1u) * nx) xb_add(&bar[XB_TOPGEN], 1u);
            else XB_SPIN(xb_ld(&bar[XB_TOPGEN]) == tg, bar);
            __builtin_amdgcn_fence(__ATOMIC_ACQUIRE, "agent");
            xb_add(&bar[XB_XGEN(b.x)], 1u);
            asm volatile("s_waitcnt vmcnt(0)" ::: "memory");
        } else {
            XB_SPIN(xb_ld(&bar[XB_XGEN(b.x)]) == gen, bar);
            __builtin_amdgcn_fence(__ATOMIC_ACQUIRE, "agent");
            asm volatile("s_waitcnt vmcnt(0)" ::: "memory");
        }
    }
    __syncthreads();
}
struct MemOrder {
    int G, c;
    __device__ bool next(int i, Unit& u) const { const int L = i * G + c; if (L >= 16) return false; u.pm = L & 1; u.pn = L >> 1; u.ord = i; return true; }
    __device__ __forceinline__ void a_ready(const Unit&) const {}
    __device__ __forceinline__ void done(const Unit&) const {}
};
constexpr int RTAB_OFF = 136192;
template <class Sched> __device__ __forceinline__ void fill_rtab(LAS unsigned char* lds, const Sched& S, const sq_t* rowsq, int wave_id) {
    const int tid = wave_id * 64 + lane_id_opaque();
    LAS float* rt = (LAS float*)(lds + RTAB_OFF);
#pragma unroll 1
    for (int i = 0; i < 8; ++i) {
        Unit u; if (!S.next(i, u)) break;
        if ((tid >> 8) == (i & 1)) rt[i * 256 + (tid & 255)] = __builtin_amdgcn_rsqf(sq_read(rowsq + u.pm * 256 + (tid & 255)) * (1.f / 1024.f) + EPS);
    }
    __syncthreads();
}
#define GRID_SYNC() _Pragma("unroll 1") for (int rs_ = 0; rs_ < REP_SYNC; ++rs_) xcd_barrier(xbar)
#define GRID_SYNC_CG() do { asm volatile("s_waitcnt vmcnt(0) lgkmcnt(0)" ::: "memory"); __syncthreads(); grid.sync(); __builtin_amdgcn_fence(__ATOMIC_ACQUIRE, "agent"); asm volatile("s_waitcnt vmcnt(0)" ::: "memory"); __syncthreads(); } while (0)
__global__ void __launch_bounds__(NWAVES * 64, 2) yoco_fwd(Params p_args_in_kernarg_segment) {
    extern __shared__ __attribute__((aligned(16))) unsigned char lds_raw[];
    LAS unsigned char* lds = (LAS unsigned char*)lds_raw;
    cg::grid_group grid = cg::this_grid();
    const int wave = __builtin_amdgcn_readfirstlane((int)threadIdx.x >> 6);
    const int G = gridDim.x, bx = blockIdx.x;
    const int gw = bx * NWAVES + wave, NGW = G * NWAVES;
    if (threadIdx.x < 16) ((LAS unsigned*)(lds + 131072))[threadIdx.x] = 0u;
    __syncthreads();
    const XcdBarrier xbar = xcd_barrier_post((unsigned*)(kparams()->ws + WS_CTL + CTL_BAR), (volatile LAS unsigned*)(lds + 131072));
    grid.sync();
#pragma unroll 1
    for (int rp = 0; rp < REP_PRO; ++rp) prologue(kparams(), lds, gw, NGW, wave, lane_id_opaque());
    GRID_SYNC();

#pragma unroll 1
    for (int ph = 0; ph < 28; ++ph) {
        const int l = ph / 7, t = ph % 7;
        const int lane = lane_id_opaque();
        const cparams_t p = kparams(); unsigned char* ws = p->ws;
        sq_t* rowsq = (sq_t*)(ws + WS_CTL + CTL_ROWSQ);
        sq_t* vsqb = (sq_t*)(ws + WS_CTL + CTL_VSQ);
        const sq_t* memsq = (const sq_t*)(ws + WS_CTL + CTL_MEMSQ);
        bf16_t* Wb = (bf16_t*)(ws + WS_W);
        bf16_t* XB = (bf16_t*)(ws + WS_XB);
        bf16_t* Hb = (bf16_t*)(ws + WS_H);
        bf16_t* Ub = (bf16_t*)(ws + WS_U); bf16_t* VTA = (bf16_t*)(ws + WS_VTA); bf16_t* QM = (bf16_t*)(ws + WS_QM); bf16_t* Pb = (bf16_t*)(ws + WS_P); bf16_t* Yb = (bf16_t*)(ws + WS_Y);
        bf16_t* Kb = (bf16_t*)(ws + WS_K); bf16_t* VTb = (bf16_t*)(ws + WS_VT);
        bf16_t* MB = (bf16_t*)(ws + WS_MEMB); bf16_t* KM = (bf16_t*)(ws + WS_KMEM); bf16_t* VMT = (bf16_t*)(ws + WS_VMEMT);
        bf16_t* Wl = Wb + (size_t)l * L_STRIDE;
        if (t == 0 || t == 5) {
            const bool kv = (t == 0 && l == 2);
            const int N = kv ? 7168 : 5632;
            const int slice = kv ? -1 : (l == 0 ? (t == 0 ? 0 : 1) : l == 1 ? (t == 0 ? 2 : 3) : (l == 2 ? 4 : -1));
            const int GG = (slice >= 0 && G >= 64) ? G - 16 : G;
            if (bx >= GG) {
                convert_items(p, (LAS float*)(lds + wave * 16384), true, slice * WI_SLICE, (slice + 1) * WI_SLICE < WI_DEFERRED ? (slice + 1) * WI_SLICE : WI_DEFERRED, (bx - GG) * NWAVES + wave, 16 * NWAVES, lane);
            } else {
                pg8::Gemm g{XB, Wl + (t == 0 ? L_GU1 : L_GU2), MROWS, N, 1024}; pg8::StaticOrder S; S.init(MROWS, N, GG, bx);
                fill_rtab(lds, S, rowsq + (size_t)(3 * l + (t == 0 ? 0 : 2)) * MROWS, wave);
                EpiSwiGLU E{Hb, (const LAS float*)(lds + RTAB_OFF), Kb, VTb};
#pragma unroll 1
                for (int rp = 0; rp < REP_GU; ++rp) pg8::gemm_phase<EpiSwiGLU, pg8::StaticOrder, true, true>(lds, g, S, E, wave);
                if (ph == 0) {
                    pg8::Gemm gm{MB, (const bf16_t*)(ws + WS_WMEM), BATCH * NMEM, 2048, 1024}; MemOrder SM{GG, (bx + 16) % GG};
                    EpiMemKV EM{KM, VMT, memsq};
                    pg8::gemm_phase<EpiMemKV, MemOrder, true, true>(lds, gm, SM, EM, wave);
                }
            }
        } else if (t == 1 || t == 4 || t == 6) {
            const bool outp = (t == 4);
            pg8::Gemm g{outp ? Yb : Hb, Wl + (t == 1 ? L_D1 : (t == 4 ? L_OUT : L_D2)), MROWS, 1024, outp ? 1024 : FF}; pg8::StaticOrder S; S.init(MROWS, 1024, G, bx);
            EpiResid E{XB, rowsq + (size_t)(3 * l + (t == 1 ? 1 : (t == 4 ? 2 : 3))) * MROWS, outp ? 1.0f : 0.5f};
            pg8::gemm_phase<EpiResid, pg8::StaticOrder, true, true>(lds, g, S, E, wave);
        } else if (t == 2) {
            const sq_t* rs = rowsq + (size_t)(3 * l + 1) * MROWS;
            if (l < 2) {
                pg8::Gemm g{XB, Wl + L_IN, MROWS, 1792, 1024}; pg8::StaticOrder S; S.init(MROWS, 1792, G, bx);
                fill_rtab(lds, S, rs, wave);
                EpiProjA E{Ub, VTA, QM, (const LAS float*)(lds + RTAB_OFF), vsqb + (size_t)l * MROWS};
#pragma unroll 1
                for (int rp = 0; rp < REP_IN; ++rp) pg8::gemm_phase<EpiProjA, pg8::StaticOrder, true, true>(lds, g, S, E, wave);
            } else {
                pg8::Gemm g{XB, Wl + L_IN, MROWS, 1024, 1024}; pg8::StaticOrder S; S.init(MROWS, 1024, G, bx);
                fill_rtab(lds, S, rs, wave);
                EpiProjB E{Pb, (const LAS float*)(lds + RTAB_OFF)};
#pragma unroll 1
                for (int rp = 0; rp < REP_IN; ++rp) pg8::gemm_phase<EpiProjB, pg8::StaticOrder, true, true>(lds, g, S, E, wave);
            }
        } else {
#pragma unroll 1
          for (int rp = 0; rp < REP_MIX; ++rp) {
            if (l < 2) {
                constexpr int NU_G = 128 * 6 * 4, NU = NU_G + 2048;
                for (int u = gw; u < NU; u += NGW) {
                    const int lane = lane_id_opaque();
                    if (u < NU_G) {
                        const int w = u / 24, rem = u % 24, g = rem >> 2, tblk = rem & 3, b = w >> 6, s0 = (w & 63) * 128, row0 = b * SEQ + s0;
                        gmlp_wave(p->a_w_sp + (size_t)(l * 6 + g) * 16384, p->a_b_sp + (l * 6 + g) * 128, p->a_v_norm + l * 768 + g * 128,
                                  VTA + (((size_t)b * (SEQ / 128) + (w & 63)) * 768 + g * 128) * 128, vsqb + (size_t)l * MROWS + row0, Ub + (size_t)row0 * 768 + g * 128, Yb + (size_t)row0 * DM + g * 128, tblk, lane, (LAS float*)(lds + 132096 + wave * 512), lds + wave * 16384);
                    } else {
                        const int v = u - NU_G, qb = v & 255, head = (v >> 8) & 3, b = v >> 10, row0 = b * SEQ + qb * 32;
                        mem_attn_wave(QM + (size_t)row0 * 256 + head * 64, 256, KM + (size_t)((l * 2 + b) * 4 + head) * 256 * 64, VMT + (size_t)((l * 2 + b) * 4 + head) * 64 * 256,
                                      Yb + (size_t)row0 * DM + 768 + head * 64, lane, lds + wave * 16384);
                    }
                }
            } else {
                constexpr int NU_S = 2 * NH * 256, NU = NU_S + 2048;
                for (int u = gw; u < NU; u += NGW) {
                    const int lane = lane_id_opaque();
                    if (u < NU_S) {
                        const int qb = u & 255, bh = u >> 8, hd = bh % NH, b = bh / NH;
                        sb_attn_wave(Pb, Kb, VTb, Yb, b, hd, qb, lane, lds + wave * 16384);
                    } else {
                        const int v = u - NU_S, qb = v & 255, head = (v >> 8) & 3, b = v >> 10, row0 = b * SEQ + qb * 32;
                        mem_attn_wave(Pb + (size_t)row0 * DM + 768 + head * 64, DM, KM + (size_t)((l * 2 + b) * 4 + head) * 256 * 64, VMT + (size_t)((l * 2 + b) * 4 + head) * 64 * 256,
                                      Yb + (size_t)row0 * DM + 768 + head * 64, lane, lds + wave * 16384);
                    }
                }
            }
          }
        }
        GRID_SYNC();
    }
    {
        const cparams_t p = kparams(); const sq_t* rs = (const sq_t*)(p->ws + WS_CTL + CTL_ROWSQ) + (size_t)12 * MROWS; const int lane = lane_id_opaque();
        const f32x4* gr = (const f32x4*)p->final_norm + lane;
        f32x4 gv[4];
#pragma unroll
        for (int j = 0; j < 4; ++j) gv[j] = gr[64 * j];
        const bf16_t* XBf = (const bf16_t*)(p->ws + WS_XB);
        for (int m = gw; m < MROWS; m += 2 * NGW) {
            const bool two = (m + NGW) < MROWS; const int m2 = two ? m + NGW : m;
            const float r0 = __builtin_amdgcn_rsqf(sq_read(rs + m) * (1.f / 1024.f) + EPS), r1 = __builtin_amdgcn_rsqf(sq_read(rs + m2) * (1.f / 1024.f) + EPS);
            const u32x2* x0 = (const u32x2*)(XBf + (size_t)m * DM) + lane; const u32x2* x1 = (const u32x2*)(XBf + (size_t)m2 * DM) + lane;
            f32x4* o0 = (f32x4*)(p->out + (size_t)m * DM) + lane; f32x4* o1 = (f32x4*)(p->out + (size_t)m2 * DM) + lane;
            u32x2 a[4], b[4];
#pragma unroll
            for (int j = 0; j < 4; ++j) { a[j] = x0[64 * j]; b[j] = x1[64 * j]; }
#pragma unroll
            for (int j = 0; j < 4; ++j) {
                const f32x4 av = {__uint_as_float(a[j].x << 16), __uint_as_float(a[j].x & 0xffff0000u), __uint_as_float(a[j].y << 16), __uint_as_float(a[j].y & 0xffff0000u)};
                const f32x4 bv = {__uint_as_float(b[j].x << 16), __uint_as_float(b[j].x & 0xffff0000u), __uint_as_float(b[j].y << 16), __uint_as_float(b[j].y & 0xffff0000u)};
                o0[64 * j] = av * r0 * gv[j]; if (two) o1[64 * j] = bv * r1 * gv[j];
            }
        }
    }
}

extern "C" void kernel_launch(void* const* d_in, const int* in_sizes, int n_in, void* d_out, int out_size, void* d_ws, size_t ws_size, hipStream_t stream) {
    static int grid = 0;
    if (grid == 0) {
        if (n_in != 23 || in_sizes[0] != MROWS * DM || out_size != MROWS * DM || ws_size < WS_END) {
            fprintf(stderr, "kernel_launch: unexpected problem (n_in %d, in0 %d, out %d, ws %zu; need ws >= %zu)\n", n_in, n_in > 0 ? in_sizes[0] : -1, out_size, ws_size, (size_t)WS_END); grid = -1; return; }
        int dev = 0, cus = 0, per_cu = 0;
        (void)hipGetDevice(&dev); (void)hipDeviceGetAttribute(&cus, hipDeviceAttributeMultiprocessorCount, dev);
        if (hipFuncSetAttribute((const void*)yoco_fwd, hipFuncAttributeMaxDynamicSharedMemorySize, LDS_BYTES) != hipSuccess) { fprintf(stderr, "kernel_launch: hipFuncSetAttribute failed\n"); grid = -1; return; }
        if (hipOccupancyMaxActiveBlocksPerMultiprocessor(&per_cu, (const void*)yoco_fwd, NWAVES * 64, LDS_BYTES) != hipSuccess || per_cu < 1) { fprintf(stderr, "kernel_launch: occupancy query failed (%d)\n", per_cu); per_cu = 1; }
        (void)hipGetLastError();
        grid = cus * 1;
        if (grid <= 0) grid = 256;
    }
    if (grid < 0) return;
    (void)hipMemsetAsync((char*)d_ws + WS_CTL, 0, CTL_BYTES, stream);
    Params p{};
    const float** pp = (const float**)&p;
    for (int i = 0; i < 23; ++i) pp[i] = (const float*)d_in[i];
    p.out = (float*)d_out; p.ws = (unsigned char*)d_ws;
    void* args[] = {&p};
    hipError_t e = hipLaunchCooperativeKernel((const void*)yoco_fwd, dim3(grid), dim3(NWAVES * 64), args, LDS_BYTES, stream);
    if (e != hipSuccess) fprintf(stderr, "kernel_launch: cooperative launch failed: %s (grid %d)\n", hipGetErrorString(e), grid);
}
```

```cpp
#include <hip/hip_runtime.h>
#include <hip/hip_cooperative_groups.h>
#include <cstdio>
#include <cstdint>
namespace cg = cooperative_groups;
__device__ __forceinline__ int lane_id_opaque() { int l = __builtin_amdgcn_mbcnt_hi(~0u, __builtin_amdgcn_mbcnt_lo(~0u, 0u)); asm volatile("" : "+v"(l)); return l; }
namespace pg8 {
#define PG8_LAS __attribute__((address_space(3)))
typedef unsigned short bf16_t;
typedef short bf16x8 __attribute__((ext_vector_type(8)));
typedef float f32x4 __attribute__((ext_vector_type(4)));
typedef unsigned u32x4 __attribute__((ext_vector_type(4)));
constexpr int BM = 256, BK = 64, HALF = 128, HTB = HALF * BK * 2  , STAGE_BYTES = 8 * HTB, NXCD = 8, WGM = 8;

__host__ __device__ __forceinline__ int lds_byte(int r, int c) { const int st = (r >> 4) * 2 + (c >> 5), rr = r & 15, cc = c & 31, ob = rr * 64 + cc * 2; return st * 1024 + (ob ^ (((ob >> 9) & 1) << 5)); }
__host__ __device__ __forceinline__ void stage_rc(int b, int& R, int& C) { const int st = b / 1024, sb = b % 1024, swz = sb ^ (((sb >> 9) & 1) << 5); R = (st >> 1) * 16 + swz / 64; C = (st & 1) * 32 + (swz % 64) / 2; }
__host__ __device__ __forceinline__ int perm32(int rho) { const int n = rho >> 4, i = rho & 15; return 8 * (i >> 2) + 4 * n + (i & 3); }

struct Unit { int pm, pn, ord; };
struct Gemm { const bf16_t* A; const bf16_t* Bt; int M, N, K; };

struct StaticOrder {
    int nM, nN, nwg, G, c;
    __host__ __device__ void init(int M, int N, int G_, int c_) { nM = M / BM; nN = N / BM; nwg = nM * nN; G = G_; c = c_; }
    __host__ __device__ bool next(int i, Unit& u) const {
        const long L = (long)i * G + c; if (L >= nwg) return false;
        int wgid = (int)L; { const int q = nwg / NXCD, r = nwg % NXCD, xcd = wgid % NXCD, off = wgid / NXCD; wgid = (xcd < r ? xcd * (q + 1) : r * (q + 1) + (xcd - r) * q) + off; }
        const int nig = WGM * nN, gid = wgid / nig, fm = gid * WGM, gsz = (nM - fm) < WGM ? (nM - fm) : WGM;
        u.pm = fm + ((wgid % nig) % gsz); u.pn = (wgid % nig) / gsz; u.ord = i; return true;
    }
    __device__ __forceinline__ void a_ready(const Unit&) const {}
    __device__ __forceinline__ void done(const Unit&) const {}
};

__device__ __forceinline__ unsigned cvt_pk_bf16(float lo, float hi) { unsigned r; asm volatile("v_cvt_pk_bf16_f32 %0, %1, %2" : "=v"(r) : "v"(lo), "v"(hi)); return r; }
typedef float f32x2 __attribute__((ext_vector_type(2)));
template <class Epi, class Sched, bool ALIGN_EPI = false, bool SP2 = false>
__device__ __forceinline__ void gemm_phase(PG8_LAS unsigned char* lds, const Gemm g, const Sched& S, const Epi& E, const int wave_id) {
    const int tid_ = wave_id * 64 + lane_id_opaque();
    const int tid = tid_, wid = __builtin_amdgcn_readfirstlane(tid >> 6), lane = tid & 63, wr = wid >> 2, wc = wid & 3, fr = lane & 15, fq = lane >> 4;
    const int K = g.K, nt = K / BK;
    unsigned voffA[2], voffB[2];
#pragma unroll
    for (int i = 0; i < 2; ++i) { int R, C; stage_rc(tid * 16 + i * 8192, R, C); const int Rb = Epi::PERM ? ((R & ~31) + perm32(R & 31)) : R;
        voffA[i] = (unsigned)(R * K + C) * 2u; voffB[i] = (unsigned)(Rb * K + C) * 2u; }
    const size_t kstep = (size_t)(BK * 2);
    const size_t hstep = (size_t)HALF * K * 2;
    const size_t tstep = 2 * hstep;
    const unsigned ldsw = (unsigned)wid * 1024u;
    const int aoff = lds_byte(wr * 64 + fr, fq * 8), boff = lds_byte(wc * 32 + fr, fq * 8);
#define PG8_SA(b, h) (((b) * 2 + (h)) * HTB)
#define PG8_SB(b, h) ((4 + (b) * 2 + (h)) * HTB)
#define PG8_STAGE(bufoff, gbase, voff) do { _Pragma("unroll") for (int _i = 0; _i < 2; ++_i) \
        __builtin_amdgcn_global_load_lds((const unsigned*)((const char*)(gbase) + (voff)[_i]), (PG8_LAS unsigned*)(lds + (bufoff) + ldsw + _i * 8192), 16, 0, 0); } while (0)
#define PG8_LDA(dst, b, h) do { _Pragma("unroll") for (int m = 0; m < 4; ++m) _Pragma("unroll") for (int k = 0; k < 2; ++k) dst[m][k] = *(const PG8_LAS bf16x8*)(lds + PG8_SA(b, h) + aoff + m * 2048 + k * 1024); } while (0)
#define PG8_LDB(dst, b, h) do { _Pragma("unroll") for (int n = 0; n < 2; ++n) _Pragma("unroll") for (int k = 0; k < 2; ++k) dst[n][k] = *(const PG8_LAS bf16x8*)(lds + PG8_SB(b, h) + boff + n * 2048 + k * 1024); } while (0)
#define PG8_MMA(ai, bj, At, Bt) do { __builtin_amdgcn_s_setprio(1); _Pragma("unroll") for (int m = 0; m < 4; ++m) _Pragma("unroll") for (int n = 0; n < 2; ++n) _Pragma("unroll") for (int k = 0; k < 2; ++k) \
        acc[ai][bj][m][n] = __builtin_amdgcn_mfma_f32_16x16x32_bf16(Bt[n][k], At[m][k], acc[ai][bj][m][n], 0, 0, 0); __builtin_amdgcn_s_setprio(0); } while (0)
#define PG8_WAIT_V(n) asm volatile("s_waitcnt vmcnt(" #n ")" ::: "memory")
#define PG8_WAIT_L(n) asm volatile("s_waitcnt lgkmcnt(" #n ")" ::: "memory")
#define PG8_BAR __builtin_amdgcn_s_barrier()
#define PG8_SCHED __builtin_amdgcn_sched_barrier(0)
    Unit cur, nxt; int ui = 0;
    if (!S.next(0, cur)) return;
    f32x4 acc[2][2][4][2];
#pragma unroll
    for (int a = 0; a < 2; ++a)
#pragma unroll
        for (int b = 0; b < 2; ++b)
#pragma unroll
            for (int m = 0; m < 4; ++m)
#pragma unroll
                for (int n = 0; n < 2; ++n) acc[a][b][m][n] = (f32x4){0.f, 0.f, 0.f, 0.f};
    bf16x8 At[4][2], B0[2][2], B1[2][2];
    const char* cA = (const char*)g.A + (size_t)cur.pm * tstep; const char* cB = (const char*)g.Bt + (size_t)cur.pn * tstep;
    S.a_ready(cur);
    if constexpr (SP2) {
        PG8_STAGE(PG8_SB(0, 0), cB, voffB); PG8_STAGE(PG8_SB(0, 1), cB + hstep, voffB); PG8_STAGE(PG8_SA(0, 0), cA, voffA); PG8_STAGE(PG8_SA(0, 1), cA + hstep, voffA);
        if (wr == 1) PG8_BAR;
        PG8_WAIT_V(2); PG8_BAR;
        PG8_STAGE(PG8_SB(1, 0), cB + kstep, voffB); PG8_STAGE(PG8_SA(1, 0), cA + kstep, voffA); PG8_STAGE(PG8_SB(1, 1), cB + hstep + kstep, voffB);
        PG8_WAIT_V(6); PG8_BAR;
    } else {
        PG8_STAGE(PG8_SB(0, 0), cB, voffB); PG8_STAGE(PG8_SA(0, 0), cA, voffA); PG8_STAGE(PG8_SB(0, 1), cB + hstep, voffB); PG8_STAGE(PG8_SA(0, 1), cA + hstep, voffA);
        if (wr == 1) PG8_BAR;
        PG8_WAIT_V(4); PG8_BAR;
        PG8_STAGE(PG8_SB(1, 0), cB + kstep, voffB); PG8_STAGE(PG8_SA(1, 0), cA + kstep, voffA); PG8_STAGE(PG8_SB(1, 1), cB + hstep + kstep, voffB);
        PG8_WAIT_V(6); PG8_BAR;
    }
    for (;;) {
        const bool has_next = S.next(ui + 1, nxt);
        const char* nA = has_next ? (const char*)g.A + (size_t)nxt.pm * tstep : cA; const char* nB = has_next ? (const char*)g.Bt + (size_t)nxt.pn * tstep : cB;
        for (int t = 0; t < nt; t += 2) {
            const bool last = (t == nt - 2);
            const char* a1 = cA + (size_t)(t + 1) * kstep;
            const char* a2 = last ? nA : cA + (size_t)(t + 2) * kstep; const char* b2 = last ? nB : cB + (size_t)(t + 2) * kstep;
            const char* a3 = a2 + kstep; const char* b3 = b2 + kstep;
            if (last && has_next) S.a_ready(nxt);
            if constexpr (SP2) {
            PG8_LDB(B0, 0, 0); PG8_LDB(B1, 0, 1); PG8_SCHED; PG8_LDA(At, 0, 0); PG8_STAGE(PG8_SA(1, 1), a1 + hstep, voffA);
            PG8_WAIT_V(8); PG8_WAIT_L(0); PG8_BAR; PG8_MMA(0, 0, At, B0); PG8_MMA(0, 1, At, B1); PG8_BAR; PG8_SCHED;
            PG8_LDA(At, 0, 1); PG8_STAGE(PG8_SB(0, 0), b2, voffB); PG8_STAGE(PG8_SB(0, 1), b2 + hstep, voffB); PG8_STAGE(PG8_SA(0, 0), a2, voffA);
            PG8_WAIT_V(8); PG8_WAIT_L(0); PG8_BAR; PG8_MMA(1, 0, At, B0); PG8_MMA(1, 1, At, B1); PG8_BAR; PG8_SCHED;
            PG8_LDB(B0, 1, 0); PG8_LDB(B1, 1, 1); PG8_SCHED; PG8_LDA(At, 1, 0); PG8_STAGE(PG8_SA(0, 1), a2 + hstep, voffA);
            PG8_WAIT_V(8); PG8_WAIT_L(0); PG8_BAR; PG8_MMA(0, 0, At, B0); PG8_MMA(0, 1, At, B1); PG8_BAR; PG8_SCHED;
            PG8_LDA(At, 1, 1); PG8_STAGE(PG8_SB(1, 0), b3, voffB); PG8_STAGE(PG8_SB(1, 1), b3 + hstep, voffB); PG8_STAGE(PG8_SA(1, 0), a3, voffA);
            PG8_WAIT_V(8); PG8_WAIT_L(0); PG8_BAR; PG8_MMA(1, 0, At, B0); PG8_MMA(1, 1, At, B1); PG8_BAR; PG8_SCHED;
            } else {
            PG8_LDB(B0, 0, 0); PG8_SCHED; PG8_LDA(At, 0, 0); PG8_STAGE(PG8_SA(1, 1), a1 + hstep, voffA);
            PG8_WAIT_L(8); PG8_BAR; PG8_WAIT_L(0); PG8_MMA(0, 0, At, B0); PG8_BAR; PG8_SCHED;
            PG8_LDB(B1, 0, 1); PG8_STAGE(PG8_SB(0, 0), b2, voffB);
            PG8_BAR; PG8_WAIT_L(0); PG8_MMA(0, 1, At, B1); PG8_BAR;
            PG8_LDA(At, 0, 1); PG8_STAGE(PG8_SA(0, 0), a2, voffA);
            PG8_BAR; PG8_WAIT_L(0); PG8_MMA(1, 0, At, B0); PG8_BAR; PG8_SCHED;
            PG8_STAGE(PG8_SB(0, 1), b2 + hstep, voffB);
            PG8_WAIT_V(6); PG8_BAR; PG8_MMA(1, 1, At, B1); PG8_BAR;
            PG8_LDB(B0, 1, 0); PG8_SCHED; PG8_LDA(At, 1, 0); PG8_STAGE(PG8_SA(0, 1), a2 + hstep, voffA);
            PG8_WAIT_L(8); PG8_BAR; PG8_WAIT_L(0); PG8_MMA(0, 0, At, B0); PG8_BAR; PG8_SCHED;
            PG8_LDB(B1, 1, 1); PG8_STAGE(PG8_SB(1, 0), b3, voffB);
            PG8_BAR; PG8_WAIT_L(0); PG8_MMA(0, 1, At, B1); PG8_BAR;
            PG8_LDA(At, 1, 1); PG8_STAGE(PG8_SA(1, 0), a3, voffA);
            PG8_BAR; PG8_WAIT_L(0); PG8_MMA(1, 0, At, B0); PG8_BAR; PG8_SCHED;
            PG8_STAGE(PG8_SB(1, 1), b3 + hstep, voffB);
            PG8_WAIT_V(6); PG8_BAR; PG8_MMA(1, 1, At, B1); PG8_BAR;
            }
        }
        if constexpr (ALIGN_EPI) { if (wr == 0) PG8_BAR; }
        if constexpr (!Epi::AFTER_DRAIN) { E(acc, cur, wr, wc, fr, fq); S.done(cur); }
        if (!has_next) break;
#pragma unroll
        for (int a = 0; a < 2; ++a)
#pragma unroll
            for (int b = 0; b < 2; ++b)
#pragma unroll
                for (int m = 0; m < 4; ++m)
#pragma unroll
                    for (int n = 0; n < 2; ++n) acc[a][b][m][n] = (f32x4){0.f, 0.f, 0.f, 0.f};
        cur = nxt; cA = nA; cB = nB; ++ui;
        if constexpr (ALIGN_EPI) { if (wr == 1) PG8_BAR; }
    }
    PG8_WAIT_V(0);
    if constexpr (!ALIGN_EPI) { if (wr == 0) PG8_BAR; }
    PG8_BAR;
    if constexpr (Epi::AFTER_DRAIN) { E.fused(acc, cur, wr, wc, fr, fq, lds, wid, lane); S.done(cur); }
#undef PG8_SA
#undef PG8_SB
#undef PG8_STAGE
#undef PG8_LDA
#undef PG8_LDB
#undef PG8_MMA
#undef PG8_WAIT_V
#undef PG8_WAIT_L
#undef PG8_BAR
#undef PG8_SCHED
}
}

using pg8::bf16_t; using pg8::f32x4; using pg8::u32x4; using pg8::Unit;
typedef short bf16x8 __attribute__((ext_vector_type(8)));
typedef float f32x16 __attribute__((ext_vector_type(16)));
typedef float f32x2v __attribute__((ext_vector_type(2)));
typedef __bf16 bf16v2 __attribute__((ext_vector_type(2)));
typedef unsigned u32x2 __attribute__((ext_vector_type(2)));
#define LAS __attribute__((address_space(3)))
#define MFMA32(a, b, c) __builtin_amdgcn_mfma_f32_32x32x16_bf16((a), (b), (c), 0, 0, 0)

constexpr int BATCH = 2, SEQ = 8192, DM = 1024, MROWS = BATCH * SEQ, FF = 2816, NMEM = 256, NH = 12;
constexpr float EPS = 1e-6f;
constexpr int NWAVES = 8;

constexpr size_t MiB = 1u << 20;
constexpr size_t WS_CTL = 0, CTL_BYTES = 3 * MiB;
constexpr size_t CTL_ROWSQ = 0;
constexpr size_t CTL_VSQ = 13 * 16384 * 8;
constexpr size_t CTL_MEMSQ = CTL_VSQ + 2 * 16384 * 8;
constexpr size_t CTL_BAR = 2 * MiB;
static_assert(CTL_MEMSQ + 4096 <= CTL_BAR && CTL_BAR + 16384 <= CTL_BYTES, "ctl");
constexpr size_t E_GU = 5632ull * 1024, E_D = 1024ull * 2816, E_INA = 1792ull * 1024, E_OUT = 1024ull * 1024;
constexpr size_t L_GU1 = 0, L_D1 = 7168ull * 1024, L_GU2 = L_D1 + E_D, L_D2 = L_GU2 + E_GU, L_IN = L_D2 + E_D, L_OUT = L_IN + E_INA, L_STRIDE = L_OUT + E_OUT;
constexpr size_t WS_W = 3 * MiB;
constexpr size_t WS_WMEM = WS_W + 4 * L_STRIDE * 2;
constexpr size_t WS_XB = 174 * MiB;
static_assert(WS_WMEM + 2048ull * 1024 * 2 <= WS_XB, "weights region");
constexpr size_t WS_H = 206 * MiB;
constexpr size_t WS_U = WS_H, WS_VTA = WS_H + 24 * MiB, WS_QM = WS_H + 48 * MiB, WS_P = WS_H, WS_Y = WS_H + 56 * MiB;
constexpr size_t WS_K = 294 * MiB, WS_VT = 318 * MiB;
constexpr size_t WS_MEMB = 342 * MiB, WS_KMEM = 343 * MiB, WS_VMEMT = 344 * MiB, WS_END = 345 * MiB;
constexpr int LDS_BYTES = 147456;
#define REP_PRO 1
#define REP_SYNC 1
#define REP_MIX 1
#define REP_GU 1
#define REP_IN 1


struct Params {
    const float *x, *mem, *ffn1_norm, *ffn1_wg, *ffn1_wu, *ffn1_wd, *mix_norm, *ffn2_norm, *ffn2_wg, *ffn2_wu, *ffn2_wd, *mem_norm, *w_mem_kv,
                *a_w_in, *a_v_norm, *a_w_sp, *a_b_sp, *a_w_out, *kv_norm, *w_kv, *b_w_in, *b_w_out, *final_norm;
    float* out; unsigned char* ws;
};

typedef const Params __attribute__((address_space(4)))* cparams_t;
__device__ __forceinline__ cparams_t kparams() { cparams_t k = (cparams_t)__builtin_amdgcn_kernarg_segment_ptr(); asm volatile("" : "+s"(k)); return k; }
__device__ __forceinline__ unsigned pk2(float a, float b) { bf16v2 v = __builtin_convertvector((f32x2v){a, b}, bf16v2); return __builtin_bit_cast(unsigned, v); }
__device__ __forceinline__ float ex2(float x) { return __builtin_amdgcn_exp2f(x); }
__device__ __forceinline__ float lg2(float x) { return __builtin_amdgcn_logf(x); }
__device__ __forceinline__ float rcpf_(float x) { return __builtin_amdgcn_rcpf(x); }
__device__ __forceinline__ float silu_f(float g) { return g * rcpf_(1.f + ex2(-1.4426950408889634f * g)); }
__device__ __forceinline__ float gelu_tanh_f(float x) { const float t = x * (1.f + 0.044715f * x * x); return x * rcpf_(1.f + ex2(-2.f * 0.7978845608028654f * 1.4426950408889634f * t)); }
typedef unsigned long long sq_t;
__device__ __forceinline__ sq_t sq_fix(float ss) { return (sq_t)(long long)(ss * 1048576.f); }
__device__ __forceinline__ void sq_add(sq_t* p, float ss) { atomicAdd(p, sq_fix(ss)); }
__device__ __forceinline__ float sq_read(const sq_t* p) { return (float)(long long)(*p) * (1.f / 1048576.f); }
__device__ __forceinline__ float wave_sum(float v) {
#pragma unroll
    for (int o = 1; o < 64; o <<= 1) v += __shfl_xor(v, o);
    return v;
}

struct EpiSwiGLU {
    static constexpr bool PERM = true, AFTER_DRAIN = false;
    bf16_t* H; const LAS float* rtab; bf16_t* Kb; bf16_t* VTb;
    __device__ __forceinline__ void operator()(const f32x4 (&acc)[2][2][4][2], const Unit& u, int wr, int wc, int fr_in, int fq_in) const {
        int fr = fr_in, fq = fq_in; asm volatile("" : "+v"(fr), "+v"(fq));
        const int row0 = u.pm * 256 + wr * 64 + fr;
        if (u.pn < 22) {
            const int col0 = u.pn * 128 + wc * 32 + 8 * fq;
#pragma unroll
            for (int ai = 0; ai < 2; ++ai)
#pragma unroll
                for (int m = 0; m < 4; ++m) {
                    const int row = row0 + ai * 128 + m * 16;
                    const float rr = rtab[u.ord * 256 + (row & 255)], cexp = -1.4426950408889634f * rr, rr2 = rr * rr;
                    float hv[8];
#pragma unroll
                    for (int n = 0; n < 2; ++n)
#pragma unroll
                        for (int j = 0; j < 4; ++j) { const float g = acc[ai][0][m][n][j]; hv[4 * n + j] = (g * acc[ai][1][m][n][j]) * rcpf_(1.f + ex2(g * cexp)) * rr2; }
                    u32x4 w; w.x = pk2(hv[0], hv[1]); w.y = pk2(hv[2], hv[3]); w.z = pk2(hv[4], hv[5]); w.w = pk2(hv[6], hv[7]);
                    *(u32x4*)(H + (size_t)row * FF + col0) = w;
                }
        } else {
            const int cb = (u.pn - 22) * 256 + wc * 32 + 8 * fq;
#pragma unroll
            for (int ai = 0; ai < 2; ++ai)
#pragma unroll
                for (int m = 0; m < 4; ++m) {
                    const int row = row0 + ai * 128 + m * 16, b = row >> 13, s = row & 8191;
                    const float rr = rtab[u.ord * 256 + (row & 255)];
#pragma unroll
                    for (int bj = 0; bj < 2; ++bj) {
                        const int c8 = cb + bj * 128;
                        float v[8];
#pragma unroll
                        for (int n = 0; n < 2; ++n)
#pragma unroll
                            for (int j = 0; j < 4; ++j) v[4 * n + j] = acc[ai][bj][m][n][j] * rr;
                        if (c8 < 768) {
                            const int hd = c8 >> 6, d = c8 & 63;
                            u32x4 w; w.x = pk2(v[0], v[1]); w.y = pk2(v[2], v[3]); w.z = pk2(v[4], v[5]); w.w = pk2(v[6], v[7]);
                            *(u32x4*)(Kb + ((size_t)(b * NH + hd) * SEQ + s) * 64 + d) = w;
                        } else {
                            const int cv = c8 - 768, hd = cv >> 6, d = cv & 63;
                            bf16_t* vp = VTb + (((size_t)(b * NH + hd) * (SEQ / 64) + (s >> 6)) * 64 + d) * 64 + (s & 63);
#pragma unroll
                            for (int e = 0; e < 8; e += 2) { const unsigned p = pk2(v[e], v[e + 1]); vp[e * 64] = (bf16_t)(p & 0xffffu); vp[(e + 1) * 64] = (bf16_t)(p >> 16); }
                        }
                    }
                }
        }
    }
};
struct EpiResid {
    static constexpr bool PERM = true, AFTER_DRAIN = false;
    bf16_t* XB; sq_t* rsq_out; float alpha;
    __device__ __forceinline__ void operator()(const f32x4 (&acc)[2][2][4][2], const Unit& u, int wr, int wc, int fr_in, int fq_in) const {
        int fr = fr_in, fq = fq_in; asm volatile("" : "+v"(fr), "+v"(fq));
        const int row0 = u.pm * 256 + wr * 64 + fr, col0 = u.pn * 256 + wc * 32 + 8 * fq;
#pragma unroll
        for (int ai = 0; ai < 2; ++ai) {
            u32x4 pre[4][2];
#pragma unroll
            for (int m = 0; m < 4; ++m)
#pragma unroll
                for (int bj = 0; bj < 2; ++bj) pre[m][bj] = *(const u32x4*)(XB + (size_t)(row0 + ai * 128 + m * 16) * DM + col0 + bj * 128);
#pragma unroll
            for (int m = 0; m < 4; ++m) {
                const int row = row0 + ai * 128 + m * 16; float ss = 0.f;
#pragma unroll
                for (int bj = 0; bj < 2; ++bj) {
                    float v[8];
#pragma unroll
                    for (int k = 0; k < 4; ++k) {
                        const unsigned w = pre[m][bj][k];
                        v[2 * k] = __uint_as_float(w << 16) + alpha * acc[ai][bj][m][k >> 1][2 * (k & 1)];
                        v[2 * k + 1] = __uint_as_float(w & 0xffff0000u) + alpha * acc[ai][bj][m][k >> 1][2 * (k & 1) + 1];
                        ss += v[2 * k] * v[2 * k] + v[2 * k + 1] * v[2 * k + 1];
                    }
                    u32x4 o; o.x = pk2(v[0], v[1]); o.y = pk2(v[2], v[3]); o.z = pk2(v[4], v[5]); o.w = pk2(v[6], v[7]);
                    *(u32x4*)(XB + (size_t)row * DM + col0 + bj * 128) = o;
                }
                ss += __shfl_xor(ss, 16); ss += __shfl_xor(ss, 32);
                if (fq == 0) sq_add(rsq_out + row, ss);
            }
            asm volatile("" ::: "memory");
        }
    }
};
struct EpiProjA {
    static constexpr bool PERM = true, AFTER_DRAIN = false;
    bf16_t* U; bf16_t* VTA; bf16_t* QM; const LAS float* rtab; sq_t* vsq;
    __device__ __forceinline__ void operator()(const f32x4 (&acc)[2][2][4][2], const Unit& u, int wr, int wc, int fr_in, int fq_in) const {
        int fr = fr_in, fq = fq_in; asm volatile("" : "+v"(fr), "+v"(fq));
        const int row0 = u.pm * 256 + wr * 64 + fr, cw = wc * 32 + 8 * fq;
#pragma unroll
        for (int ai = 0; ai < 2; ++ai)
#pragma unroll
            for (int m = 0; m < 4; ++m) {
                const int row = row0 + ai * 128 + m * 16, b = row >> 13, s = row & 8191;
                const float rr = rtab[u.ord * 256 + (row & 255)];
                float ss = 0.f;
#pragma unroll
                for (int bj = 0; bj < 2; ++bj) {
                    float v[8];
#pragma unroll
                    for (int n = 0; n < 2; ++n)
#pragma unroll
                        for (int j = 0; j < 4; ++j) v[4 * n + j] = acc[ai][bj][m][n][j] * rr;
                    if (u.pn < 6) {
#pragma unroll
                        for (int e = 0; e < 8; ++e) v[e] = gelu_tanh_f(v[e]);
                    }
                    if (u.pn < 3) {
                        u32x4 w; w.x = pk2(v[0], v[1]); w.y = pk2(v[2], v[3]); w.z = pk2(v[4], v[5]); w.w = pk2(v[6], v[7]);
                        *(u32x4*)(U + (size_t)row * 768 + u.pn * 256 + bj * 128 + cw) = w;
                    } else if (u.pn < 6) {
                        const int cv = (u.pn - 3) * 256 + bj * 128 + cw;
                        bf16_t* vp = VTA + (((size_t)b * (SEQ / 128) + (s >> 7)) * 768 + cv) * 128 + (s & 127);
#pragma unroll
                        for (int e = 0; e < 8; e += 2) { ss += v[e] * v[e] + v[e + 1] * v[e + 1]; const unsigned p = pk2(v[e], v[e + 1]); vp[e * 128] = (bf16_t)(p & 0xffffu); vp[(e + 1) * 128] = (bf16_t)(p >> 16); }
                    } else {
                        u32x4 w; w.x = pk2(v[0], v[1]); w.y = pk2(v[2], v[3]); w.z = pk2(v[4], v[5]); w.w = pk2(v[6], v[7]);
                        *(u32x4*)(QM + (size_t)row * 256 + bj * 128 + cw) = w;
                    }
                }
                if (u.pn >= 3 && u.pn < 6) { ss += __shfl_xor(ss, 16); ss += __shfl_xor(ss, 32); if (fq == 0) sq_add(vsq + row, ss); }
            }
    }
};
struct EpiProjB {
    static constexpr bool PERM = true, AFTER_DRAIN = false;
    bf16_t* P; const LAS float* rtab;
    __device__ __forceinline__ void operator()(const f32x4 (&acc)[2][2][4][2], const Unit& u, int wr, int wc, int fr_in, int fq_in) const {
        int fr = fr_in, fq = fq_in; asm volatile("" : "+v"(fr), "+v"(fq));
        const int row0 = u.pm * 256 + wr * 64 + fr, col0 = u.pn * 256 + wc * 32 + 8 * fq;
#pragma unroll
        for (int ai = 0; ai < 2; ++ai)
#pragma unroll
            for (int m = 0; m < 4; ++m) {
                const int row = row0 + ai * 128 + m * 16;
                const float rr = rtab[u.ord * 256 + (row & 255)];
#pragma unroll
                for (int bj = 0; bj < 2; ++bj) {
                    const f32x4 v0 = acc[ai][bj][m][0] * rr, v1 = acc[ai][bj][m][1] * rr;
                    u32x4 w; w.x = pk2(v0[0], v0[1]); w.y = pk2(v0[2], v0[3]); w.z = pk2(v1[0], v1[1]); w.w = pk2(v1[2], v1[3]);
                    *(u32x4*)(P + (size_t)row * DM + col0 + bj * 128) = w;
                }
            }
    }
};
struct EpiMemKV {
    static constexpr bool PERM = true, AFTER_DRAIN = false;
    bf16_t* KM; bf16_t* VMT; const sq_t* memsq;
    __device__ __forceinline__ void operator()(const f32x4 (&acc)[2][2][4][2], const Unit& u, int wr, int wc, int fr_in, int fq_in) const {
        int fr = fr_in, fq = fq_in; asm volatile("" : "+v"(fr), "+v"(fq));
        const int row0 = u.pm * 256 + wr * 64 + fr;
#pragma unroll
        for (int ai = 0; ai < 2; ++ai)
#pragma unroll
            for (int m = 0; m < 4; ++m) {
                const int row = row0 + ai * 128 + m * 16, b = row >> 8, key = row & 255;
                const float rr = __builtin_amdgcn_rsqf(sq_read(memsq + row) * (1.f / 1024.f) + EPS);
#pragma unroll
                for (int bj = 0; bj < 2; ++bj) {
                    const int c = u.pn * 256 + bj * 128 + wc * 32 + 8 * fq, l = c >> 9, cc = c & 511;
                    float v[8];
#pragma unroll
                    for (int n = 0; n < 2; ++n)
#pragma unroll
                        for (int j = 0; j < 4; ++j) v[4 * n + j] = acc[ai][bj][m][n][j] * rr;
                    if (cc < 256) {
                        const int head = cc >> 6, d = cc & 63;
                        u32x4 w; w.x = pk2(v[0], v[1]); w.y = pk2(v[2], v[3]); w.z = pk2(v[4], v[5]); w.w = pk2(v[6], v[7]);
                        *(u32x4*)(KM + ((size_t)((l * 2 + b) * 4 + head) * 256 + key) * 64 + d) = w;
                    } else {
                        const int cv = cc - 256, head = cv >> 6, d = cv & 63;
                        bf16_t* vp = VMT + (((size_t)((l * 2 + b) * 4 + head) * 4 + (key >> 6)) * 64 + d) * 64 + (key & 63);
#pragma unroll
                        for (int e = 0; e < 8; e += 2) { const unsigned p = pk2(v[e], v[e + 1]); vp[e * 64] = (bf16_t)(p & 0xffffu); vp[(e + 1) * 64] = (bf16_t)(p >> 16); }
                    }
                }
            }
    }
};


__device__ __forceinline__ void tile_load(const bf16_t* __restrict__ g, size_t gstride, u32x4 (&r)[8], int lane) {
    const bf16_t* p = g + (size_t)(lane >> 3) * gstride + 8 * (lane & 7);
#pragma unroll
    for (int i = 0; i < 8; ++i) r[i] = *(const u32x4*)(p + (size_t)(8 * i) * gstride);
}
__device__ __forceinline__ void tile_store(LAS unsigned char* t, const u32x4 (&r)[8], int lane) {
#pragma unroll
    for (int i = 0; i < 8; ++i) { const int row = 8 * i + (lane >> 3); *(LAS u32x4*)(t + row * 128 + ((((lane & 7) ^ (row >> 1)) & 7) << 4)) = r[i]; }
}
__device__ __forceinline__ bf16x8 tile_frag(const LAS unsigned char* t, int row, int chunk) { return *(const LAS bf16x8*)(t + row * 128 + (((chunk ^ (row >> 1)) & 7) << 4)); }

__device__ __forceinline__ void qtile_to_frags(const bf16_t* __restrict__ g  , size_t pitch, LAS unsigned char* img  , bf16x8 (&qf)[4], int lane) {
    u32x4 r[4];
    const bf16_t* p = g + (size_t)(lane >> 3) * pitch + 8 * (lane & 7);
#pragma unroll
    for (int i = 0; i < 4; ++i) r[i] = *(const u32x4*)(p + (size_t)(8 * i) * pitch);
#pragma unroll
    for (int i = 0; i < 4; ++i) { const int row = 8 * i + (lane >> 3); *(LAS u32x4*)(img + row * 128 + ((((lane & 7) ^ (row >> 1)) & 7) << 4)) = r[i]; }
#pragma unroll
    for (int ks = 0; ks < 4; ++ks) qf[ks] = tile_frag(img, lane & 31, 2 * ks + (lane >> 5));
}
__device__ __forceinline__ void otile_store(const f32x16& o0, const f32x16& o1, float scale, LAS unsigned char* img  , bf16_t* __restrict__ g  , int lane) {
    const int q = lane & 31, h = lane >> 5;
#pragma unroll
    for (int g4 = 0; g4 < 4; ++g4) {
        u32x2 w0, w1;
        w0.x = pk2(o0[4 * g4] * scale, o0[4 * g4 + 1] * scale); w0.y = pk2(o0[4 * g4 + 2] * scale, o0[4 * g4 + 3] * scale);
        w1.x = pk2(o1[4 * g4] * scale, o1[4 * g4 + 1] * scale); w1.y = pk2(o1[4 * g4 + 2] * scale, o1[4 * g4 + 3] * scale);
        *(LAS u32x2*)(img + q * 128 + (((g4 ^ (q >> 1)) & 7) << 4) + 8 * h) = w0;
        *(LAS u32x2*)(img + q * 128 + ((((4 + g4) ^ (q >> 1)) & 7) << 4) + 8 * h) = w1;
    }
#pragma unroll
    for (int i = 0; i < 4; ++i) { const int row = 8 * i + (lane >> 3), c = lane & 7; const u32x4 v = *(const LAS u32x4*)(img + row * 128 + (((c ^ (row >> 1)) & 7) << 4)); *(u32x4*)(g + (size_t)row * DM + 8 * c) = v; }
}

__device__ __forceinline__ void sb_attn_wave(const bf16_t* __restrict__ P, const bf16_t* __restrict__ Kb, const bf16_t* __restrict__ VTb, bf16_t* __restrict__ Y, int b, int hd, int qb, int lane, LAS unsigned char* tl  ) {
    const int q = lane & 31, h = lane >> 5;
    const int kap = 16 * ((q >> 2) & 1) + (q & 3) + 4 * (q >> 3);
    const int qpos = qb * 32 + q;
    bf16x8 qf[4];
    const bf16_t* Kh = Kb + (size_t)(b * NH + hd) * SEQ * 64;
    const bf16_t* Vh = VTb + (size_t)(b * NH + hd) * 64 * SEQ;
    LAS unsigned char* Kt = tl; LAS unsigned char* Vt = tl + 8192;
    u32x4 rk[8], rv[8];
    { const int kf = ((qb * 32 + 31) >> 6) * 64; tile_load(Kh + (size_t)kf * 64, 64, rk, lane); tile_load(Vh + (size_t)kf * 64, 64, rv, lane); }
    qtile_to_frags(P + (size_t)(b * SEQ + qb * 32) * DM + hd * 64, DM, Vt, qf, lane);
    f32x16 o0, o1;
#pragma unroll
    for (int i = 0; i < 16; ++i) { o0[i] = 0.f; o1[i] = 0.f; }
    float carry = 1.f;
    const float c1 = 0.125f * 1.4426950408889634f;
    for (int kt = (qb * 32 + 31) >> 6; kt >= 0; --kt) {
        const int k0 = kt * 64;
        tile_store(Kt, rk, lane); tile_store(Vt, rv, lane);
        if (kt > 0) { tile_load(Kh + (size_t)(k0 - 64) * 64, 64, rk, lane); tile_load(Vh + (size_t)(k0 - 64) * 64, 64, rv, lane); }
        f32x16 s0, s1;
#pragma unroll
        for (int i = 0; i < 16; ++i) { s0[i] = 0.f; s1[i] = 0.f; }
#pragma unroll
        for (int ks = 0; ks < 4; ++ks) {
            const bf16x8 a0 = tile_frag(Kt, kap, 2 * ks + h), a1 = tile_frag(Kt, 32 + kap, 2 * ks + h);
            s0 = MFMA32(a0, qf[ks], s0); s1 = MFMA32(a1, qf[ks], s1);
        }
        const int kb0 = k0 + 16 * h, kb1 = kb0 + 32;
        float T0 = 1.f, T1 = 1.f;
#pragma unroll
        for (int r = 0; r < 16; ++r) {
            { const float z = s0[r] * c1; const float t = ex2(-fabsf(z)); const float rc = rcpf_(1.f + t), tr = t * rc; const bool cz = (kb0 + r < qpos); s0[r] = cz ? (z >= 0.f ? rc : tr) : 0.f; T0 *= cz ? (z >= 0.f ? tr : rc) : 1.f; }
            { const float z = s1[r] * c1; const float t = ex2(-fabsf(z)); const float rc = rcpf_(1.f + t), tr = t * rc; const bool cz = (kb1 + r < qpos); s1[r] = cz ? (z >= 0.f ? rc : tr) : 0.f; T1 *= cz ? (z >= 0.f ? tr : rc) : 1.f; }
        }
        const float To0 = __shfl_xor(T0, 32), To1 = __shfl_xor(T1, 32);
        const float off1 = h ? 1.f : To1;
        const float off0 = h ? (To1 * T1) : (To0 * (T1 * To1));
        float run = carry * off1;
#pragma unroll
        for (int r = 15; r >= 0; --r) { const float be = s1[r]; s1[r] = be * run; run *= (1.f - be); }
        run = carry * off0;
#pragma unroll
        for (int r = 15; r >= 0; --r) { const float be = s0[r]; s0[r] = be * run; run *= (1.f - be); }
        carry *= (T0 * T1) * (To0 * To1);
#pragma unroll
        for (int s2 = 0; s2 < 2; ++s2) {
            u32x4 p0, p1;
            p0.x = pk2(s0[8 * s2 + 0], s0[8 * s2 + 1]); p0.y = pk2(s0[8 * s2 + 2], s0[8 * s2 + 3]); p0.z = pk2(s0[8 * s2 + 4], s0[8 * s2 + 5]); p0.w = pk2(s0[8 * s2 + 6], s0[8 * s2 + 7]);
            p1.x = pk2(s1[8 * s2 + 0], s1[8 * s2 + 1]); p1.y = pk2(s1[8 * s2 + 2], s1[8 * s2 + 3]); p1.z = pk2(s1[8 * s2 + 4], s1[8 * s2 + 5]); p1.w = pk2(s1[8 * s2 + 6], s1[8 * s2 + 7]);
            const bf16x8 pf0 = __builtin_bit_cast(bf16x8, p0), pf1 = __builtin_bit_cast(bf16x8, p1);
            const bf16x8 va00 = tile_frag(Vt, q, 2 * h + s2), va01 = tile_frag(Vt, 32 + q, 2 * h + s2);
            const bf16x8 va10 = tile_frag(Vt, q, 4 + 2 * h + s2), va11 = tile_frag(Vt, 32 + q, 4 + 2 * h + s2);
            o0 = MFMA32(va00, pf0, o0); o1 = MFMA32(va01, pf0, o1);
            o0 = MFMA32(va10, pf1, o0); o1 = MFMA32(va11, pf1, o1);
        }
        if (__all(carry < 1e-37f)) break;
    }
    otile_store(o0, o1, 1.f, Kt, Y + (size_t)(b * SEQ + qb * 32) * DM + hd * 64, lane);
}

__device__ __forceinline__ void mem_attn_wave(const bf16_t* __restrict__ Qrow  , int qpitch, const bf16_t* __restrict__ Km  , const bf16_t* __restrict__ Vm  ,
                                              bf16_t* __restrict__ Yrow  , int lane, LAS unsigned char* tl  ) {
    const int q = lane & 31, h = lane >> 5;
    const int kap = 16 * ((q >> 2) & 1) + (q & 3) + 4 * (q >> 3);
    bf16x8 qf[4];
    LAS unsigned char* Kt = tl; LAS unsigned char* Vt = tl + 8192;
    u32x4 rk[8], rv[8];
    tile_load(Km, 64, rk, lane); tile_load(Vm, 64, rv, lane);
    qtile_to_frags(Qrow, (size_t)qpitch, Vt, qf, lane);
    f32x16 o0, o1;
#pragma unroll
    for (int i = 0; i < 16; ++i) { o0[i] = 0.f; o1[i] = 0.f; }
    const float c1 = 0.125f * 1.4426950408889634f;
    float mrun = -3.0e38f, sum = 0.f;
#pragma unroll 1
    for (int t = 0; t < 4; ++t) {
        tile_store(Kt, rk, lane); tile_store(Vt, rv, lane);
        if (t < 3) { tile_load(Km + (size_t)(t + 1) * 64 * 64, 64, rk, lane); tile_load(Vm + (size_t)(t + 1) * 64 * 64, 64, rv, lane); }
        f32x16 s0, s1;
#pragma unroll
        for (int i = 0; i < 16; ++i) { s0[i] = 0.f; s1[i] = 0.f; }
#pragma unroll
        for (int ks = 0; ks < 4; ++ks) { s0 = MFMA32(tile_frag(Kt, kap, 2 * ks + h), qf[ks], s0); s1 = MFMA32(tile_frag(Kt, 32 + kap, 2 * ks + h), qf[ks], s1); }
        float mt = -3.0e38f;
#pragma unroll
        for (int i = 0; i < 16; ++i) mt = fmaxf(mt, fmaxf(s0[i], s1[i]));
        mt = fmaxf(mt, __shfl_xor(mt, 32));
        const float mnew = fmaxf(mrun, mt), alpha = ex2((mrun - mnew) * c1), mb = mnew * c1;
        mrun = mnew; sum *= alpha;
#pragma unroll
        for (int i = 0; i < 16; ++i) { const float p0 = ex2(s0[i] * c1 - mb), p1 = ex2(s1[i] * c1 - mb); s0[i] = p0; s1[i] = p1; sum += p0 + p1; o0[i] *= alpha; o1[i] *= alpha; }
#pragma unroll
        for (int s2 = 0; s2 < 2; ++s2) {
            u32x4 p0, p1;
            p0.x = pk2(s0[8 * s2 + 0], s0[8 * s2 + 1]); p0.y = pk2(s0[8 * s2 + 2], s0[8 * s2 + 3]); p0.z = pk2(s0[8 * s2 + 4], s0[8 * s2 + 5]); p0.w = pk2(s0[8 * s2 + 6], s0[8 * s2 + 7]);
            p1.x = pk2(s1[8 * s2 + 0], s1[8 * s2 + 1]); p1.y = pk2(s1[8 * s2 + 2], s1[8 * s2 + 3]); p1.z = pk2(s1[8 * s2 + 4], s1[8 * s2 + 5]); p1.w = pk2(s1[8 * s2 + 6], s1[8 * s2 + 7]);
            const bf16x8 pf0 = __builtin_bit_cast(bf16x8, p0), pf1 = __builtin_bit_cast(bf16x8, p1);
            o0 = MFMA32(tile_frag(Vt, q, 2 * h + s2), pf0, o0); o1 = MFMA32(tile_frag(Vt, 32 + q, 2 * h + s2), pf0, o1);
            o0 = MFMA32(tile_frag(Vt, q, 4 + 2 * h + s2), pf1, o0); o1 = MFMA32(tile_frag(Vt, 32 + q, 4 + 2 * h + s2), pf1, o1);
        }
    }
    sum += __shfl_xor(sum, 32);
    otile_store(o0, o1, 1.f / sum, Kt, Yrow, lane);
}

__device__ __forceinline__ void gmlp_wave(const float* __restrict__ Wg  , const float* __restrict__ bias  , const float* __restrict__ gain  ,
                                          const bf16_t* __restrict__ VT  , const sq_t* __restrict__ vsq  , const bf16_t* __restrict__ Ur  ,
                                          bf16_t* __restrict__ Yr  , int tblk, int lane, LAS float* rvs  , LAS unsigned char* tl  ) {
    const int q = lane & 31, h = lane >> 5;
    f32x16 X[4];
#pragma unroll
    for (int cb = 0; cb < 4; ++cb)
#pragma unroll
        for (int i = 0; i < 16; ++i) X[cb][i] = 0.f;
    const int nsh = tblk < 2 ? 1 : 2;
    u32x4 rk[8];
    tile_load(VT, 128, rk, lane);
    {
        f32x2v r; r.x = __builtin_amdgcn_rsqf(sq_read(vsq + 2 * lane) * (1.f / 768.f) + EPS); r.y = __builtin_amdgcn_rsqf(sq_read(vsq + 2 * lane + 1) * (1.f / 768.f) + EPS);
        *(LAS f32x2v*)(rvs + 2 * lane) = r; asm volatile("s_waitcnt lgkmcnt(0)" ::: "memory");
    }
    const float* wld = Wg + (32 * tblk + (lane >> 4)) * 128 + 4 * (lane & 15);
    f32x4 rw[8];
#pragma unroll
    for (int i = 0; i < 8; ++i) rw[i] = *(const f32x4*)(wld + (4 * i) * 128);
#pragma unroll 1
    for (int sh = 0; sh < nsh; ++sh) {
        bf16x8 af[4];
        {
            LAS unsigned char* wimg = tl + 8192;
#pragma unroll
            for (int i = 0; i < 8; ++i) { const int tl_ = 4 * i + (lane >> 4), rho = 2 * tl_ + ((lane >> 3) & 1); *(LAS f32x4*)(wimg + rho * 128 + ((((lane & 7) ^ tl_) & 7) << 4)) = rw[i]; }
            if (sh + 1 < nsh) {
#pragma unroll
                for (int i = 0; i < 8; ++i) rw[i] = *(const f32x4*)(wld + (4 * i) * 128 + 64 * (sh + 1));
            }
        }
#pragma unroll
        for (int k4 = 0; k4 < 4; ++k4) {
            const int ks = 4 * sh + k4;
            const LAS unsigned char* wr_ = tl + 8192 + (2 * q + (k4 >> 1)) * 128; const int c16 = 4 * (k4 & 1) + 2 * h;
            const f32x4 w0 = *(const LAS f32x4*)(wr_ + (((c16 ^ q) & 7) << 4)), w1 = *(const LAS f32x4*)(wr_ + ((((c16 + 1) ^ q) & 7) << 4));
            const f32x4 q0 = *(const LAS f32x4*)(rvs + 16 * ks + 8 * h), q1 = *(const LAS f32x4*)(rvs + 16 * ks + 8 * h + 4);
            u32x4 ap; ap.x = pk2(w0[0] * q0[0], w0[1] * q0[1]); ap.y = pk2(w0[2] * q0[2], w0[3] * q0[3]); ap.z = pk2(w1[0] * q1[0], w1[1] * q1[1]); ap.w = pk2(w1[2] * q1[2], w1[3] * q1[3]);
            af[k4] = __builtin_bit_cast(bf16x8, ap);
        }
#pragma unroll
        for (int ch = 0; ch < 2; ++ch) {
            LAS unsigned char* img = tl + ch * 8192;
            tile_store(img, rk, lane);
            if (ch == 0) tile_load(VT + 64 * 128 + 64 * sh, 128, rk, lane);
            else if (sh + 1 < nsh) tile_load(VT + 64 * (sh + 1), 128, rk, lane);
#pragma unroll
            for (int k4 = 0; k4 < 4; ++k4)
#pragma unroll
                for (int c2 = 0; c2 < 2; ++c2) X[2 * ch + c2] = MFMA32(af[k4], tile_frag(img, 32 * c2 + q, 2 * k4 + h), X[2 * ch + c2]);
        }
    }
    LAS float* mt = (LAS float*)tl;
    f32x4 bv[4];
#pragma unroll
    for (int g4 = 0; g4 < 4; ++g4) bv[g4] = *(const f32x4*)(bias + 32 * tblk + 8 * g4 + 4 * h);
#pragma unroll
    for (int cb = 0; cb < 4; ++cb) {
        const float gn = gain[32 * cb + q];
#pragma unroll
        for (int i = 0; i < 16; ++i) mt[((i & 3) + 8 * (i >> 2) + 4 * h) * 128 + 32 * cb + q] = gn * X[cb][i] + bv[i >> 2][i & 3];
    }
#pragma unroll
    for (int i8 = 0; i8 < 8; ++i8) {
        const int t = 4 * i8 + (lane >> 4), c8 = 8 * (lane & 15);
        const u32x4 uu = *(const u32x4*)(Ur + (size_t)(32 * tblk + t) * 768 + c8);
        const f32x4 m0 = *(const LAS f32x4*)(mt + t * 128 + c8), m1 = *(const LAS f32x4*)(mt + t * 128 + c8 + 4);
        u32x4 o;
        o.x = pk2(__uint_as_float(uu.x << 16) * m0[0], __uint_as_float(uu.x & 0xffff0000u) * m0[1]); o.y = pk2(__uint_as_float(uu.y << 16) * m0[2], __uint_as_float(uu.y & 0xffff0000u) * m0[3]);
        o.z = pk2(__uint_as_float(uu.z << 16) * m1[0], __uint_as_float(uu.z & 0xffff0000u) * m1[1]); o.w = pk2(__uint_as_float(uu.w << 16) * m1[2], __uint_as_float(uu.w & 0xffff0000u) * m1[3]);
        *(u32x4*)(Yr + (size_t)(32 * tblk + t) * DM + c8) = o;
    }
}

#define LDS_WAIT() asm volatile("s_waitcnt lgkmcnt(0)" ::: "memory")
struct WItem { const float* src; const float* g; bf16_t* dst; int N, K, k0, n0, drow0; bool valid; };
__device__ __forceinline__ WItem witem_decode(const cparams_t p, int it) {
    constexpr int IT_G = 16 * 88, IT_MEM = 16 * 16, IT_IN = 16 * 56, IT_OUT = 16 * 32, IT_LAYER = 6 * IT_G + IT_MEM + IT_IN + IT_OUT;
    bf16_t* Wb = (bf16_t*)(p->ws + WS_W);
    WItem w; w.g = nullptr; w.K = 1024; w.valid = true;
    if (it >= 4 * IT_LAYER) {
        const int r = it - 4 * IT_LAYER; w.N = 1536; w.k0 = 64 * (r / 48); w.n0 = 32 * (r % 48); w.drow0 = 5632 + w.n0; w.src = p->w_kv; w.g = p->kv_norm; w.dst = Wb + 2 * L_STRIDE + L_GU1;
    } else {
        const int l = it / IT_LAYER; int r = it % IT_LAYER; bf16_t* Wl = Wb + (size_t)l * L_STRIDE;
        if (r < 6 * IT_G) {
            const int j = r / IT_G, rr = r % IT_G, half = j / 3, kind = j % 3;
            if (kind < 2) {
                w.N = FF; w.k0 = 64 * (rr / 88); w.n0 = 32 * (rr % 88); w.drow0 = 256 * (w.n0 >> 7) + (w.n0 & 127) + 128 * kind;
                w.src = (half ? (kind ? p->ffn2_wu : p->ffn2_wg) : (kind ? p->ffn1_wu : p->ffn1_wg)) + (size_t)l * 1024 * FF;
                w.g = (half ? p->ffn2_norm : p->ffn1_norm) + l * 1024; w.dst = Wl + (half ? L_GU2 : L_GU1);
            } else {
                w.K = FF; w.N = 1024; w.k0 = 64 * (rr / 32); w.n0 = 32 * (rr % 32); w.drow0 = w.n0;
                w.src = (half ? p->ffn2_wd : p->ffn1_wd) + (size_t)l * FF * 1024; w.dst = Wl + (half ? L_D2 : L_D1);
            }
        } else {
            r -= 6 * IT_G;
            if (r < IT_MEM) { w.N = 512; w.k0 = 64 * (r / 16); w.n0 = 32 * (r % 16); w.drow0 = l * 512 + w.n0; w.src = p->w_mem_kv + (size_t)l * 1024 * 512; w.g = p->mem_norm; w.dst = (bf16_t*)(p->ws + WS_WMEM); }
            else {
                r -= IT_MEM;
                if (r < IT_IN) {
                    if (l < 2) { w.N = 1792; w.k0 = 64 * (r / 56); w.n0 = 32 * (r % 56); w.src = p->a_w_in + (size_t)l * 1024 * 1792; }
                    else { w.valid = r < 512; r &= 511; w.N = 1024; w.k0 = 64 * (r / 32); w.n0 = 32 * (r % 32); w.src = p->b_w_in + (size_t)(l - 2) * 1024 * 1024; }
                    w.drow0 = w.n0; w.g = p->mix_norm + l * 1024; w.dst = Wl + L_IN;
                } else {
                    r -= IT_IN; w.N = 1024; w.k0 = 64 * (r / 32); w.n0 = 32 * (r % 32); w.drow0 = w.n0;
                    w.src = (l < 2 ? p->a_w_out + (size_t)l * 1024 * 1024 : p->b_w_out + (size_t)(l - 2) * 1024 * 1024); w.dst = Wl + L_OUT;
                }
            }
        }
    }
    return w;
}
__device__ __forceinline__ void witem_load(const WItem& w, f32x4 (&v)[8], float (&gs)[8], int lane) {
    const float* sp = w.src + (size_t)(w.k0 + (lane >> 3)) * w.N + w.n0 + 4 * (lane & 7);
#pragma unroll
    for (int i = 0; i < 8; ++i) { v[i] = *(const f32x4*)(sp + (size_t)(8 * i) * w.N); gs[i] = w.g ? w.g[w.k0 + 8 * i + (lane >> 3)] : 1.f; }
}
__device__ __forceinline__ void witem_store(const WItem& w, const f32x4 (&v)[8], const float (&gs)[8], LAS float* scr, int lane) {
#pragma unroll
    for (int i = 0; i < 8; ++i) { LAS float* d = scr + (8 * i + (lane >> 3)) * 33 + 4 * (lane & 7); d[0] = v[i][0] * gs[i]; d[1] = v[i][1] * gs[i]; d[2] = v[i][2] * gs[i]; d[3] = v[i][3] * gs[i]; }
    LDS_WAIT();
    const int c = lane & 7;
#pragma unroll
    for (int j = 0; j < 4; ++j) { const int n = (lane >> 3) + 8 * j; const LAS float* s = scr + (8 * c) * 33 + n;
        u32x4 o; o.x = pk2(s[0 * 33], s[1 * 33]); o.y = pk2(s[2 * 33], s[3 * 33]); o.z = pk2(s[4 * 33], s[5 * 33]); o.w = pk2(s[6 * 33], s[7 * 33]);
        *(u32x4*)(w.dst + (size_t)(w.drow0 + n) * w.K + w.k0 + 8 * c) = o; }
    LDS_WAIT();
}

constexpr int WI_G = 16 * 88, WI_MEM = 16 * 16, WI_LAYER = 6 * WI_G + WI_MEM + 16 * 56 + 16 * 32, WI_KV = 16 * 48;
constexpr int WI_UPFRONT = WI_LAYER + 3 * WI_MEM, WI_DEFERRED = 3 * WI_LAYER + WI_KV, WI_SLICE = (WI_DEFERRED + 4) / 5;
__device__ __forceinline__ int wi_map(bool deferred, int i, bool& skip) {
    skip = false;
    if (!deferred) { if (i < WI_LAYER) return i; const int m = i - WI_LAYER; return (1 + m / WI_MEM) * WI_LAYER + 6 * WI_G + (m % WI_MEM); }
    int it;
    if (i < 2 * WI_LAYER) it = WI_LAYER + i; else if (i < 2 * WI_LAYER + WI_KV) return 4 * WI_LAYER + (i - 2 * WI_LAYER); else it = 3 * WI_LAYER + (i - 2 * WI_LAYER - WI_KV);
    const int r = it % WI_LAYER; skip = (r >= 6 * WI_G && r < 6 * WI_G + WI_MEM);
    return it;
}
__device__ __forceinline__ void convert_items(const cparams_t p, LAS float* scr, bool deferred, int lo, int hi, int w, int NW, int lane) {
    int i = lo + w; if (i >= hi) return;
    bool sk; WItem cur = witem_decode(p, wi_map(deferred, i, sk)); cur.valid = cur.valid && !sk; f32x4 v[8]; float gs[8];
    if (cur.valid) witem_load(cur, v, gs, lane);
    for (;;) {
        const int in_ = i + NW; const bool has = in_ < hi;
        WItem nx = cur; f32x4 v2[8]; float gs2[8];
        if (has) { bool sk2; nx = witem_decode(p, wi_map(deferred, in_, sk2)); nx.valid = nx.valid && !sk2; if (nx.valid) witem_load(nx, v2, gs2, lane); }
        if (cur.valid) witem_store(cur, v, gs, scr, lane);
        if (!has) break;
        cur = nx; i = in_;
#pragma unroll
        for (int k = 0; k < 8; ++k) { v[k] = v2[k]; gs[k] = gs2[k]; }
    }
}
__device__ __forceinline__ void prologue(const cparams_t p, LAS unsigned char* lds, int gw, int NGW, int wave, int lane) {
    LAS float* scr = (LAS float*)(lds + wave * 16384);
    convert_items(p, scr, false, 0, WI_UPFRONT, gw, NGW, lane);
    sq_t* rs0 = (sq_t*)(p->ws + WS_CTL + CTL_ROWSQ);
    bf16_t* XB = (bf16_t*)(p->ws + WS_XB);
    for (int m = gw; m < MROWS; m += 2 * NGW) {
        const bool two = (m + NGW) < MROWS; const int m2 = two ? m + NGW : m;
        const f32x4* xr = (const f32x4*)(p->x + (size_t)m * DM) + lane; u32x2* brow = (u32x2*)(XB + (size_t)m * DM) + lane;
        const f32x4* xr2 = (const f32x4*)(p->x + (size_t)m2 * DM) + lane; u32x2* brow2 = (u32x2*)(XB + (size_t)m2 * DM) + lane;
        f32x4 va[4], vb[4];
#pragma unroll
        for (int j = 0; j < 4; ++j) { va[j] = xr[64 * j]; vb[j] = xr2[64 * j]; }
        float ss = 0.f, ss2 = 0.f;
#pragma unroll
        for (int j = 0; j < 4; ++j) {
            u32x2 w; w.x = pk2(va[j][0], va[j][1]); w.y = pk2(va[j][2], va[j][3]); brow[64 * j] = w; ss += (va[j][0] * va[j][0] + va[j][1] * va[j][1]) + (va[j][2] * va[j][2] + va[j][3] * va[j][3]);
            u32x2 w2; w2.x = pk2(vb[j][0], vb[j][1]); w2.y = pk2(vb[j][2], vb[j][3]); if (two) brow2[64 * j] = w2; ss2 += (vb[j][0] * vb[j][0] + vb[j][1] * vb[j][1]) + (vb[j][2] * vb[j][2] + vb[j][3] * vb[j][3]);
        }
        ss = wave_sum(ss); ss2 = wave_sum(ss2);
        if (lane == 0) { rs0[m] = sq_fix(ss); if (two) rs0[m2] = sq_fix(ss2); }
    }
    sq_t* msq = (sq_t*)(p->ws + WS_CTL + CTL_MEMSQ);
    bf16_t* MB = (bf16_t*)(p->ws + WS_MEMB);
    for (int m = gw; m < BATCH * NMEM; m += NGW) {
        const f32x4* xr = (const f32x4*)(p->mem + (size_t)m * DM) + lane; u32x2* brow = (u32x2*)(MB + (size_t)m * DM) + lane;
        float ss = 0.f;
#pragma unroll
        for (int j = 0; j < 4; ++j) { const f32x4 v = xr[64 * j]; u32x2 w; w.x = pk2(v[0], v[1]); w.y = pk2(v[2], v[3]); brow[64 * j] = w; ss += (v[0] * v[0] + v[1] * v[1]) + (v[2] * v[2] + v[3] * v[3]); }
        ss = wave_sum(ss);
        if (lane == 0) msq[m] = sq_fix(ss);
    }
}

#define XB_TMO      128
#define XB_XCNT(j)  (256  + 64 * (j))
#define XB_XSUB(j)  (1280 + 64 * (j))
#define XB_XGEN(j)  (2304 + 64 * (j))
#define XB_TOP      3328
#define XB_TOPGEN   3392
#define XCD_BAR_WORDS 3456
#define XB_SPIN_CAP (1u << 18)

__device__ __forceinline__ unsigned xb_ld(unsigned* p)              { return __hip_atomic_load(p, __ATOMIC_RELAXED, __HIP_MEMORY_SCOPE_AGENT); }
__device__ __forceinline__ unsigned xb_add(unsigned* p, unsigned v) { return __hip_atomic_fetch_add(p, v, __ATOMIC_RELAXED, __HIP_MEMORY_SCOPE_AGENT); }
__device__ __forceinline__ unsigned xb_xcc_id() { return (unsigned)__builtin_amdgcn_s_getreg((3 << 11) | 20) & 0xFu; }
#define XB_SPIN(cond, bar) do { unsigned _sp = 0; while (cond) { __builtin_amdgcn_s_sleep(1); \
    if ((++_sp & 255u) == 0u) { if (xb_ld(&(bar)[XB_TMO])) break; if (_sp > XB_SPIN_CAP) { atomicAdd(&(bar)[XB_TMO], 1u); break; } } } } while (0)

struct XcdBarrier {
    unsigned* bar; unsigned x;
    volatile LAS unsigned* st;
};

__device__ __forceinline__ XcdBarrier xcd_barrier_post(unsigned* bar, volatile LAS unsigned* st) {
    XcdBarrier b; b.bar = bar; b.x = xb_xcc_id(); b.st = st;
    if (threadIdx.x == 0) (void)xb_add(&bar[XB_XCNT(b.x)], 1u);
    return b;
}
__device__ __forceinline__ void xcd_barrier_complete(unsigned* bar, unsigned x, unsigned& nloc, unsigned& nx) {
    const unsigned G = gridDim.x * gridDim.y * gridDim.z;
    unsigned sum, cnt, mine, sp = 0u;
    for (;;) {
        sum = 0u; cnt = 0u; mine = 0u;
#pragma unroll
        for (unsigned j = 0; j < 16; ++j) { const unsigned c = xb_ld(&bar[XB_XCNT(j)]); sum += c; cnt += (c > 0u) ? 1u : 0u; mine = (j == x) ? c : mine; }
        if (sum == G) break;
        __builtin_amdgcn_s_sleep(1);
        if ((++sp & 255u) == 0u) { if (xb_ld(&bar[XB_TMO])) break; if (sp > XB_SPIN_CAP) { atomicAdd(&bar[XB_TMO], 1u); break; } }
    }
    nloc = mine > 0u ? mine : 1u; nx = cnt > 0u ? cnt : 1u;
}

__device__ __forceinline__ void xcd_barrier(const XcdBarrier& b) {
    asm volatile("s_waitcnt vmcnt(0)" ::: "memory");
    __syncthreads();
    if (threadIdx.x == 0) {
        unsigned* bar = b.bar;
        __builtin_amdgcn_s_waitcnt(0);
        unsigned nloc = b.st[0], nx = b.st[1];
        if (nloc == 0u) { xcd_barrier_complete(bar, b.x, nloc, nx); b.st[0] = nloc; b.st[1] = nx; }
        const unsigned old = xb_add(&bar[XB_XSUB(b.x)], 1u);
        const unsigned gen = old / nloc;
        if (old + 1u == (gen + 1u) * nloc) {
            __builtin_amdgcn_fence(__ATOMIC_RELEASE, "agent");
            asm volatile("s_waitcnt vmcnt(0)" ::: "memory");
            const unsigned og = xb_add(&bar[XB_TOP], 1u);
            const unsigned tg = og / nx;
            if (og + 1u == (tg + 1u) * nx) xb_add(&bar[XB_TOPGEN], 1u);
            else XB_SPIN(xb_ld(&bar[XB_TOPGEN]) == tg, bar);
            __builtin_amdgcn_fence(__ATOMIC_ACQUIRE, "agent");
            xb_add(&bar[XB_XGEN(b.x)], 1u);
            asm volatile("s_waitcnt vmcnt(0)" ::: "memory");
        } else {
            XB_SPIN(xb_ld(&bar[XB_XGEN(b.x)]) == gen, bar);
            __builtin_amdgcn_fence(__ATOMIC_ACQUIRE, "agent");
            asm volatile("s_waitcnt vmcnt(0)" ::: "memory");
        }
    }
    __syncthreads();
}
struct MemOrder {
    int G, c;
    __device__ bool next(int i, Unit& u) const { const int L = i * G + c; if (L >= 16) return false; u.pm = L & 1; u.pn = L >> 1; u.ord = i; return true; }
    __device__ __forceinline__ void a_ready(const Unit&) const {}
    __device__ __forceinline__ void done(const Unit&) const {}
};
constexpr int RTAB_OFF = 136192;
template <class Sched> __device__ __forceinline__ void fill_rtab(LAS unsigned char* lds, const Sched& S, const sq_t* rowsq, int wave_id) {
    const int tid = wave_id * 64 + lane_id_opaque();
    LAS float* rt = (LAS float*)(lds + RTAB_OFF);
#pragma unroll 1
    for (int i = 0; i < 8; ++i) {
        Unit u; if (!S.next(i, u)) break;
        if ((tid >> 8) == (i & 1)) rt[i * 256 + (tid & 255)] = __builtin_amdgcn_rsqf(sq_read(rowsq + u.pm * 256 + (tid & 255)) * (1.f / 1024.f) + EPS);
    }
    __syncthreads();
}
#define GRID_SYNC() _Pragma("unroll 1") for (int rs_ = 0; rs_ < REP_SYNC; ++rs_) xcd_barrier(xbar)
#define GRID_SYNC_CG() do { asm volatile("s_waitcnt vmcnt(0) lgkmcnt(0)" ::: "memory"); __syncthreads(); grid.sync(); __builtin_amdgcn_fence(__ATOMIC_ACQUIRE, "agent"); asm volatile("s_waitcnt vmcnt(0)" ::: "memory"); __syncthreads(); } while (0)
__global__ void __launch_bounds__(NWAVES * 64, 2) yoco_fwd(Params p_args_in_kernarg_segment) {
    extern __shared__ __attribute__((aligned(16))) unsigned char lds_raw[];
    LAS unsigned char* lds = (LAS unsigned char*)lds_raw;
    cg::grid_group grid = cg::this_grid();
    const int wave = __builtin_amdgcn_readfirstlane((int)threadIdx.x >> 6);
    const int G = gridDim.x, bx = blockIdx.x;
    const int gw = bx * NWAVES + wave, NGW = G * NWAVES;
    if (threadIdx.x < 16) ((LAS unsigned*)(lds + 131072))[threadIdx.x] = 0u;
    __syncthreads();
    XcdBarrier xbar; xbar.bar = (unsigned*)(kparams()->ws + WS_CTL + CTL_BAR); xbar.x = xb_xcc_id(); xbar.st = (volatile LAS unsigned*)(lds + 131072);
    if (threadIdx.x == 0) xbar.st[4] = xb_add(&xbar.bar[XB_XCNT(xbar.x)], 1u);
    grid.sync();
#pragma unroll 1
    for (int rp = 0; rp < REP_PRO; ++rp) prologue(kparams(), lds, gw, NGW, wave, lane_id_opaque());
    GRID_SYNC();
    if (threadIdx.x == 0) {
        unsigned ok = (G % 8 == 0) ? 1u : 0u;
#pragma unroll 1
        for (unsigned j = 0; j < 16; ++j) { const unsigned c = xb_ld(&xbar.bar[XB_XCNT(j)]); ok &= (j < 8 ? (c == (unsigned)(G / 8)) : (c == 0u)) ? 1u : 0u; }
        xbar.st[5] = ok;
    }
    __syncthreads();
    const bool realp = __builtin_amdgcn_readfirstlane((int)xbar.st[5]) != 0;
    const int rank_ = __builtin_amdgcn_readfirstlane((int)xbar.st[4]);
    const int cv = realp ? rank_ * 8 + (int)xbar.x : bx;
    const int gwm = (realp ? (int)xbar.x * (G / 8) + rank_ : bx) * NWAVES + wave;

#pragma unroll 1
    for (int ph = 0; ph < 28; ++ph) {
        const int l = ph / 7, t = ph % 7;
        const int lane = lane_id_opaque();
        const cparams_t p = kparams(); unsigned char* ws = p->ws;
        sq_t* rowsq = (sq_t*)(ws + WS_CTL + CTL_ROWSQ);
        sq_t* vsqb = (sq_t*)(ws + WS_CTL + CTL_VSQ);
        const sq_t* memsq = (const sq_t*)(ws + WS_CTL + CTL_MEMSQ);
        bf16_t* Wb = (bf16_t*)(ws + WS_W);
        bf16_t* XB = (bf16_t*)(ws + WS_XB);
        bf16_t* Hb = (bf16_t*)(ws + WS_H);
        bf16_t* Ub = (bf16_t*)(ws + WS_U); bf16_t* VTA = (bf16_t*)(ws + WS_VTA); bf16_t* QM = (bf16_t*)(ws + WS_QM); bf16_t* Pb = (bf16_t*)(ws + WS_P); bf16_t* Yb = (bf16_t*)(ws + WS_Y);
        bf16_t* Kb = (bf16_t*)(ws + WS_K); bf16_t* VTb = (bf16_t*)(ws + WS_VT);
        bf16_t* MB = (bf16_t*)(ws + WS_MEMB); bf16_t* KM = (bf16_t*)(ws + WS_KMEM); bf16_t* VMT = (bf16_t*)(ws + WS_VMEMT);
        bf16_t* Wl = Wb + (size_t)l * L_STRIDE;
        if (t == 0 || t == 5) {
            const bool kv = (t == 0 && l == 2);
            const int N = kv ? 7168 : 5632;
            const int slice = kv ? -1 : (l == 0 ? (t == 0 ? 0 : 1) : l == 1 ? (t == 0 ? 2 : 3) : (l == 2 ? 4 : -1));
            const int GG = (slice >= 0 && G >= 64) ? G - 16 : G;
            if (cv >= GG) {
                convert_items(p, (LAS float*)(lds + wave * 16384), true, slice * WI_SLICE, (slice + 1) * WI_SLICE < WI_DEFERRED ? (slice + 1) * WI_SLICE : WI_DEFERRED, (cv - GG) * NWAVES + wave, 16 * NWAVES, lane);
            } else {
                pg8::Gemm g{XB, Wl + (t == 0 ? L_GU1 : L_GU2), MROWS, N, 1024}; pg8::StaticOrder S; S.init(MROWS, N, GG, cv);
                fill_rtab(lds, S, rowsq + (size_t)(3 * l + (t == 0 ? 0 : 2)) * MROWS, wave);
                EpiSwiGLU E{Hb, (const LAS float*)(lds + RTAB_OFF), Kb, VTb};
#pragma unroll 1
                for (int rp = 0; rp < REP_GU; ++rp) pg8::gemm_phase<EpiSwiGLU, pg8::StaticOrder, true, true>(lds, g, S, E, wave);
                if (ph == 0) {
                    pg8::Gemm gm{MB, (const bf16_t*)(ws + WS_WMEM), BATCH * NMEM, 2048, 1024}; MemOrder SM{GG, (cv + 16) % GG};
                    EpiMemKV EM{KM, VMT, memsq};
                    pg8::gemm_phase<EpiMemKV, MemOrder, true, true>(lds, gm, SM, EM, wave);
                }
            }
        } else if (t == 1 || t == 4 || t == 6) {
            const bool outp = (t == 4);
            pg8::Gemm g{outp ? Yb : Hb, Wl + (t == 1 ? L_D1 : (t == 4 ? L_OUT : L_D2)), MROWS, 1024, outp ? 1024 : FF}; pg8::StaticOrder S; S.init(MROWS, 1024, G, cv);
            EpiResid E{XB, rowsq + (size_t)(3 * l + (t == 1 ? 1 : (t == 4 ? 2 : 3))) * MROWS, outp ? 1.0f : 0.5f};
            pg8::gemm_phase<EpiResid, pg8::StaticOrder, true, true>(lds, g, S, E, wave);
        } else if (t == 2) {
            const sq_t* rs = rowsq + (size_t)(3 * l + 1) * MROWS;
            if (l < 2) {
                pg8::Gemm g{XB, Wl + L_IN, MROWS, 1792, 1024}; pg8::StaticOrder S; S.init(MROWS, 1792, G, cv);
                fill_rtab(lds, S, rs, wave);
                EpiProjA E{Ub, VTA, QM, (const LAS float*)(lds + RTAB_OFF), vsqb + (size_t)l * MROWS};
#pragma unroll 1
                for (int rp = 0; rp < REP_IN; ++rp) pg8::gemm_phase<EpiProjA, pg8::StaticOrder, true, true>(lds, g, S, E, wave);
            } else {
                pg8::Gemm g{XB, Wl + L_IN, MROWS, 1024, 1024}; pg8::StaticOrder S; S.init(MROWS, 1024, G, cv);
                fill_rtab(lds, S, rs, wave);
                EpiProjB E{Pb, (const LAS float*)(lds + RTAB_OFF)};
#pragma unroll 1
                for (int rp = 0; rp < REP_IN; ++rp) pg8::gemm_phase<EpiProjB, pg8::StaticOrder, true, true>(lds, g, S, E, wave);
            }
        } else {
#pragma unroll 1
          for (int rp = 0; rp < REP_MIX; ++rp) {
            if (l < 2) {
                constexpr int NU_G = 128 * 6 * 4, NU = NU_G + 2048;
                for (int u = gwm; u < NU; u += NGW) {
                    const int lane = lane_id_opaque();
                    if (u < NU_G) {
                        const int w = u / 24, rem = u % 24, g = rem >> 2, tblk = rem & 3, b = w >> 6, s0 = (w & 63) * 128, row0 = b * SEQ + s0;
                        gmlp_wave(p->a_w_sp + (size_t)(l * 6 + g) * 16384, p->a_b_sp + (l * 6 + g) * 128, p->a_v_norm + l * 768 + g * 128,
                                  VTA + (((size_t)b * (SEQ / 128) + (w & 63)) * 768 + g * 128) * 128, vsqb + (size_t)l * MROWS + row0, Ub + (size_t)row0 * 768 + g * 128, Yb + (size_t)row0 * DM + g * 128, tblk, lane, (LAS float*)(lds + 132096 + wave * 512), lds + wave * 16384);
                    } else {
                        const int v = u - NU_G, qb = v & 255, head = (v >> 8) & 3, b = v >> 10, row0 = b * SEQ + qb * 32;
                        mem_attn_wave(QM + (size_t)row0 * 256 + head * 64, 256, KM + (size_t)((l * 2 + b) * 4 + head) * 256 * 64, VMT + (size_t)((l * 2 + b) * 4 + head) * 64 * 256,
                                      Yb + (size_t)row0 * DM + 768 + head * 64, lane, lds + wave * 16384);
                    }
                }
            } else {
                constexpr int NU_S = 2 * NH * 256, NU = NU_S + 2048;
                for (int u = gwm; u < NU; u += NGW) {
                    const int lane = lane_id_opaque();
                    if (u < NU_S) {
                        const int qb = u & 255, bh = u >> 8, hd = bh % NH, b = bh / NH;
                        sb_attn_wave(Pb, Kb, VTb, Yb, b, hd, qb, lane, lds + wave * 16384);
                    } else {
                        const int v = u - NU_S, qb = v & 255, head = (v >> 8) & 3, b = v >> 10, row0 = b * SEQ + qb * 32;
                        mem_attn_wave(Pb + (size_t)row0 * DM + 768 + head * 64, DM, KM + (size_t)((l * 2 + b) * 4 + head) * 256 * 64, VMT + (size_t)((l * 2 + b) * 4 + head) * 64 * 256,
                                      Yb + (size_t)row0 * DM + 768 + head * 64, lane, lds + wave * 16384);
                    }
                }
            }
          }
        }
        GRID_SYNC();
    }
    {
        const cparams_t p = kparams(); const sq_t* rs = (const sq_t*)(p->ws + WS_CTL + CTL_ROWSQ) + (size_t)12 * MROWS; const int lane = lane_id_opaque();
        const f32x4* gr = (const f32x4*)p->final_norm + lane;
        f32x4 gv[4];
#pragma unroll
        for (int j = 0; j < 4; ++j) gv[j] = gr[64 * j];
        const bf16_t* XBf = (const bf16_t*)(p->ws + WS_XB);
        for (int m = gw; m < MROWS; m += 2 * NGW) {
            const bool two = (m + NGW) < MROWS; const int m2 = two ? m + NGW : m;
            const float r0 = __builtin_amdgcn_rsqf(sq_read(rs + m) * (1.f / 1024.f) + EPS), r1 = __builtin_amdgcn_rsqf(sq_read(rs + m2) * (1.f / 1024.f) + EPS);
            const u32x2* x0 = (const u32x2*)(XBf + (size_t)m * DM) + lane; const u32x2* x1 = (const u32x2*)(XBf + (size_t)m2 * DM) + lane;
            f32x4* o0 = (f32x4*)(p->out + (size_t)m * DM) + lane; f32x4* o1 = (f32x4*)(p->out + (size_t)m2 * DM) + lane;
            u32x2 a[4], b[4];
#pragma unroll
            for (int j = 0; j < 4; ++j) { a[j] = x0[64 * j]; b[j] = x1[64 * j]; }
#pragma unroll
            for (int j = 0; j < 4; ++j) {
                const f32x4 av = {__uint_as_float(a[j].x << 16), __uint_as_float(a[j].x & 0xffff0000u), __uint_as_float(a[j].y << 16), __uint_as_float(a[j].y & 0xffff0000u)};
                const f32x4 bv = {__uint_as_float(b[j].x << 16), __uint_as_float(b[j].x & 0xffff0000u), __uint_as_float(b[j].y << 16), __uint_as_float(b[j].y & 0xffff0000u)};
                o0[64 * j] = av * r0 * gv[j]; if (two) o1[64 * j] = bv * r1 * gv[j];
            }
        }
    }
}

extern "C" void kernel_launch(void* const* d_in, const int* in_sizes, int n_in, void* d_out, int out_size, void* d_ws, size_t ws_size, hipStream_t stream) {
    static int grid = 0;
    if (grid == 0) {
        if (n_in != 23 || in_sizes[0] != MROWS * DM || out_size != MROWS * DM || ws_size < WS_END) {
            fprintf(stderr, "kernel_launch: unexpected problem (n_in %d, in0 %d, out %d, ws %zu; need ws >= %zu)\n", n_in, n_in > 0 ? in_sizes[0] : -1, out_size, ws_size, (size_t)WS_END); grid = -1; return; }
        int dev = 0, cus = 0, per_cu = 0;
        (void)hipGetDevice(&dev); (void)hipDeviceGetAttribute(&cus, hipDeviceAttributeMultiprocessorCount, dev);
        if (hipFuncSetAttribute((const void*)yoco_fwd, hipFuncAttributeMaxDynamicSharedMemorySize, LDS_BYTES) != hipSuccess) { fprintf(stderr, "kernel_launch: hipFuncSetAttribute failed\n"); grid = -1; return; }
        if (hipOccupancyMaxActiveBlocksPerMultiprocessor(&per_cu, (const void*)yoco_fwd, NWAVES * 64, LDS_BYTES) != hipSuccess || per_cu < 1) { fprintf(stderr, "kernel_launch: occupancy query failed (%d)\n", per_cu); per_cu = 1; }
        (void)hipGetLastError();
        grid = cus * 1;
        if (grid <= 0) grid = 256;
    }
    if (grid < 0) return;
    (void)hipMemsetAsync((char*)d_ws + WS_CTL, 0, CTL_BYTES, stream);
    Params p{};
    const float** pp = (const float**)&p;
    for (int i = 0; i < 23; ++i) pp[i] = (const float*)d_in[i];
    p.out = (float*)d_out; p.ws = (unsigned char*)d_ws;
    void* args[] = {&p};
    hipError_t e = hipLaunchCooperativeKernel((const void*)yoco_fwd, dim3(grid), dim3(NWAVES * 64), args, LDS_BYTES, stream);
    if (e != hipSuccess) fprintf(stderr, "kernel_launch: cooperative launch failed: %s (grid %d)\n", hipGetErrorString(e), grid);
}
```
